# Optimizing an MI355X kernel written in HIP

```python
import jax, jax.numpy as jnp
from jax import lax
import numpy as np

D_MODEL = 2048
BATCH = 4
SEQ = 2048
DEPTH = 2
DEC_BATCH = 128
DEC_SEQ = 4
PAST_LEN = 16384
PAGE_SIZE = 128

N_MIXERS = 2
N_POOL_LAYERS = (DEPTH + 1) // 2
N_RET_LAYERS = DEPTH // 2
POOL_WINDOWS = (2, 4, 8, 16)
POOL_GROUPS = len(POOL_WINDOWS)
POOL_GW = D_MODEL // POOL_GROUPS
POOL_BUF = max(POOL_WINDOWS) - 1
RET_HEADS = 8
RET_DK = D_MODEL // RET_HEADS
RET_DV = 2 * RET_DK
RET_QK = RET_HEADS * RET_DK
RET_V = RET_HEADS * RET_DV
RET_CHUNK = 128
ROPE_BASE = 10000.0
FFN_DIM = 5632
CONV_W = 3
PLE_DIM = 256
EPS = 1e-6

kernel_name = "hybrid_pool_retention_decoder_step"

F32 = jnp.float32


def _rmsnorm(x, g):
    xf = x.astype(F32)
    y = xf * lax.rsqrt(jnp.mean(xf * xf, axis=-1, keepdims=True) + EPS)
    return (y * g.astype(F32)).astype(x.dtype)


def _pool_mixer(h, buf, pos0, w, scale):
    B, T, D = h.shape
    h_ext = jnp.concatenate([buf.astype(h.dtype), h], axis=1)
    cs = jnp.cumsum(h_ext.astype(F32), axis=1)
    cs = jnp.concatenate([jnp.zeros((B, 1, D), F32), cs], axis=1)
    pos = pos0 + jnp.arange(T)
    P = POOL_BUF
    outs = []
    for gi, win in enumerate(POOL_WINDOWS):
        sl = slice(gi * POOL_GW, (gi + 1) * POOL_GW)
        hi = cs[:, P + 1:P + 1 + T, sl]
        lo = cs[:, P + 1 - win:P + 1 - win + T, sl]
        cnt = jnp.minimum(pos + 1, win).astype(F32)[None, :, None]
        d = (hi - lo) / cnt - h[..., sl].astype(F32)
        outs.append(jnp.einsum('btc,cd->btd', d.astype(h.dtype), w[gi]))
    y = jnp.concatenate(outs, axis=-1) * scale
    return y, h_ext[:, -P:]


def _rotary(x, pos):
    half = RET_DK // 2
    inv = ROPE_BASE ** (-jnp.arange(half, dtype=F32) / half)
    ang = pos.astype(F32)[:, None] * inv[None, :]
    cos, sin = jnp.cos(ang), jnp.sin(ang)
    x1, x2 = x[..., :half], x[..., half:]
    return jnp.concatenate([x1 * cos - x2 * sin, x1 * sin + x2 * cos], axis=-1)


def _retention_decays(C):
    log_g = jnp.log1p(-(2.0 ** (-5.0 - jnp.arange(RET_HEADS, dtype=F32))))
    n = jnp.arange(C, dtype=F32)
    diff = n[:, None] - n[None, :]
    intra = jnp.where(diff >= 0, jnp.exp(log_g[:, None, None] * jnp.maximum(diff, 0.0)), 0.0)
    cross = jnp.exp(log_g[:, None] * (n + 1.0))
    kdec = jnp.exp(log_g[:, None] * (C - 1.0 - n))
    sdec = jnp.exp(log_g * C)
    return intra, cross, kdec, sdec


def _retention(h, s0, pos0, w_in, w_out):
    B, T, _ = h.shape
    proj = jnp.einsum('btd,de->bte', h, w_in)
    q = proj[..., :RET_QK]
    k = proj[..., RET_QK:2 * RET_QK]
    v = proj[..., 2 * RET_QK:2 * RET_QK + RET_V]
    g = proj[..., 2 * RET_QK + RET_V:]

    def heads(t, dh):
        return t.reshape(B, T, RET_HEADS, dh).transpose(0, 2, 1, 3).astype(F32)

    pos = pos0 + jnp.arange(T)
    q = _rotary(heads(q, RET_DK), pos)
    k = _rotary(heads(k, RET_DK), pos) * (RET_DK ** -0.5)
    v = heads(v, RET_DV)
    C = RET_CHUNK if T % RET_CHUNK == 0 else T
    nc = T // C
    intra, cross, kdec, sdec = _retention_decays(C)

    def to_chunks(t):
        return jnp.moveaxis(t.reshape(B, RET_HEADS, nc, C, t.shape[-1]), 2, 0)

    def step(S, qkv):
        qc, kc, vc = qkv
        sc = jnp.einsum('bhnk,bhmk->bhnm', qc, kc) * intra
        o = (jnp.einsum('bhnm,bhmv->bhnv', sc, vc)
             + jnp.einsum('bhnk,bhkv->bhnv', qc, S) * cross[None, :, :, None])
        S = sdec[None, :, None, None] * S + jnp.einsum('bhmk,bhmv->bhkv', kc * kdec[None, :, :, None], vc)
        return S, o

    s_new, o = lax.scan(step, s0.astype(F32), (to_chunks(q), to_chunks(k), to_chunks(v)))
    o = jnp.moveaxis(o, 0, 2).reshape(B, RET_HEADS, T, RET_DV)
    mu = jnp.mean(o, axis=-1, keepdims=True)
    var = jnp.mean(jnp.square(o - mu), axis=-1, keepdims=True)
    o = (o - mu) * lax.rsqrt(var + EPS)
    o = o.transpose(0, 2, 1, 3).reshape(B, T, RET_V)
    y = jnp.einsum('btv,vd->btd', (jax.nn.silu(g.astype(F32)) * o).astype(h.dtype), w_out)
    return y, s_new


def _conv_ffn(h, buf, w_up, cw, cb, w_down):
    T = h.shape[1]
    u = jnp.einsum('btd,df->btf', h, w_up)
    u_ext = jnp.concatenate([buf.astype(u.dtype), u], axis=1)
    c = cw[0] * u_ext[:, :T] + cw[1] * u_ext[:, 1:T + 1] + cw[2] * u_ext[:, 2:T + 2] + cb
    gate, up = c[..., :FFN_DIM], c[..., FFN_DIM:]
    y = jnp.einsum('btf,fd->btd', jax.nn.silu(gate) * up, w_down)
    return y, u_ext[:, -(CONV_W - 1):]


def _trunk(x, p, pool_bufs, ret_states, conv_bufs, pos0, norm_mix, norm_ffn, norm_ple, norm_final,
           pool_w, pool_scale, ret_w_in, ret_w_out, ffn_w_up, ffn_conv_w, ffn_conv_b, ffn_w_down,
           ple_w_proj, ple_w_gate):
    new_pool, new_ret, new_conv = [], [], []
    for i in range(DEPTH):
        h = _rmsnorm(x, norm_mix[i])
        j = i // N_MIXERS
        if i % N_MIXERS == 0:
            y, nb = _pool_mixer(h, pool_bufs[j], pos0, pool_w[j], pool_scale[j])
            new_pool.append(nb)
        else:
            y, ns = _retention(h, ret_states[j], pos0, ret_w_in[j], ret_w_out[j])
            new_ret.append(ns)
        x = x + y
        h = _rmsnorm(x, norm_ffn[i])
        y, nc = _conv_ffn(h, conv_bufs[i], ffn_w_up[i], ffn_conv_w[i], ffn_conv_b[i], ffn_w_down[i])
        new_conv.append(nc)
        x = x + y
        gate = jax.nn.sigmoid(jnp.einsum('btd,de->bte', _rmsnorm(x, norm_ple[i]), ple_w_gate[i]).astype(F32))
        emb = jnp.einsum('btp,pd->btd', p[i].astype(x.dtype), ple_w_proj[i])
        x = x + (gate * emb.astype(F32)).astype(x.dtype)
    return _rmsnorm(x, norm_final), jnp.stack(new_pool), jnp.stack(new_ret), jnp.stack(new_conv)


def setup_inputs(seed: int = 0) -> dict:
    key = jax.random.key(seed)
    ks = jax.random.split(key, 24)
    nrm = jax.random.normal
    F2 = 2 * FFN_DIM
    return {
        "x_prompt": nrm(ks[0], (BATCH, SEQ, D_MODEL), F32),
        "x_sample": nrm(ks[1], (DEC_BATCH, DEC_SEQ, D_MODEL), F32),
        "p_prompt": nrm(ks[2], (DEPTH, BATCH, SEQ, PLE_DIM), F32),
        "p_sample": nrm(ks[3], (DEPTH, DEC_BATCH, DEC_SEQ, PLE_DIM), F32),
        "state_pool": nrm(ks[4], (N_POOL_LAYERS, DEC_BATCH, POOL_BUF, D_MODEL), F32),
        "state_ret": 0.1 * nrm(ks[5], (N_RET_LAYERS, DEC_BATCH, RET_HEADS, RET_DK, RET_DV), F32),
        "state_conv": nrm(ks[6], (DEPTH, DEC_BATCH, CONV_W - 1, F2), F32),
        "norm_mix": 1.0 + 0.02 * nrm(ks[7], (DEPTH, D_MODEL), F32),
        "norm_ffn": 1.0 + 0.02 * nrm(ks[8], (DEPTH, D_MODEL), F32),
        "norm_ple": 1.0 + 0.02 * nrm(ks[9], (DEPTH, D_MODEL), F32),
        "norm_final": 1.0 + 0.02 * nrm(ks[10], (D_MODEL,), F32),
        "pool_w": nrm(ks[11], (N_POOL_LAYERS, POOL_GROUPS, POOL_GW, POOL_GW), F32) * POOL_GW ** -0.5,
        "pool_scale": 0.5 + 0.05 * nrm(ks[12], (N_POOL_LAYERS, D_MODEL), F32),
        "ret_w_in": nrm(ks[13], (N_RET_LAYERS, D_MODEL, 2 * RET_QK + 2 * RET_V), F32) * D_MODEL ** -0.5,
        "ret_w_out": nrm(ks[14], (N_RET_LAYERS, RET_V, D_MODEL), F32) * RET_V ** -0.5,
        "ffn_w_up": nrm(ks[15], (DEPTH, D_MODEL, F2), F32) * D_MODEL ** -0.5,
        "ffn_conv_w": 0.5 * nrm(ks[16], (DEPTH, CONV_W, F2), F32),
        "ffn_conv_b": 0.01 * nrm(ks[17], (DEPTH, F2), F32),
        "ffn_w_down": nrm(ks[18], (DEPTH, FFN_DIM, D_MODEL), F32) * FFN_DIM ** -0.5,
        "ple_w_proj": nrm(ks[19], (DEPTH, PLE_DIM, D_MODEL), F32) * PLE_DIM ** -0.5,
        "ple_w_gate": nrm(ks[20], (DEPTH, D_MODEL, D_MODEL), F32) * D_MODEL ** -0.5,
    }


def reference(x_prompt, x_sample, p_prompt, p_sample, state_pool, state_ret, state_conv,
              norm_mix, norm_ffn, norm_ple, norm_final, pool_w, pool_scale, ret_w_in, ret_w_out,
              ffn_w_up, ffn_conv_w, ffn_conv_b, ffn_w_down, ple_w_proj, ple_w_gate):
    dt = x_prompt.dtype
    zero_pool = jnp.zeros((N_POOL_LAYERS, BATCH, POOL_BUF, D_MODEL), dt)
    zero_ret = jnp.zeros((N_RET_LAYERS, BATCH, RET_HEADS, RET_DK, RET_DV), F32)
    zero_conv = jnp.zeros((DEPTH, BATCH, CONV_W - 1, 2 * FFN_DIM), dt)
    y_prompt, pool_p, ret_p, conv_p = _trunk(
        x_prompt, p_prompt, zero_pool, zero_ret, zero_conv, 0,
        norm_mix, norm_ffn, norm_ple, norm_final, pool_w, pool_scale, ret_w_in, ret_w_out,
        ffn_w_up, ffn_conv_w, ffn_conv_b, ffn_w_down, ple_w_proj, ple_w_gate)
    y_sample, pool_s, ret_s, conv_s = _trunk(
        x_sample, p_sample, state_pool, state_ret, state_conv, PAST_LEN,
        norm_mix, norm_ffn, norm_ple, norm_final, pool_w, pool_scale, ret_w_in, ret_w_out,
        ffn_w_up, ffn_conv_w, ffn_conv_b, ffn_w_down, ple_w_proj, ple_w_gate)
    return (y_prompt, y_sample, pool_p, pool_s, ret_p, ret_s, conv_p, conv_s)
```

```cpp
#include <hip/hip_runtime.h>
#include <cstdio>
#include <cstdint>

#ifndef MK_ONE_LAUNCH
#define MK_ONE_LAUNCH 1
#endif

#ifndef PROBE_DUP
#define PROBE_DUP 0
#endif
#define REP(k) _Pragma("unroll") for (int rep_ = 0; rep_ < 1 + ((PROBE_DUP >> (k)) & 1); ++rep_)
#define LAS __attribute__((address_space(3)))
#define GAS __attribute__((address_space(1)))
typedef unsigned short bf16;
typedef short bf16x8 __attribute__((ext_vector_type(8)));
typedef short s16x4 __attribute__((ext_vector_type(4)));
typedef float f32x4 __attribute__((ext_vector_type(4)));
typedef float f32x2 __attribute__((ext_vector_type(2)));
typedef unsigned u32x4 __attribute__((ext_vector_type(4)));
typedef unsigned u32x2 __attribute__((ext_vector_type(2)));
typedef GAS unsigned gu32;

constexpr int D = 2048, NB = 4, SEQ = 2048, DB = 128, DS = 4;
constexpr int MP = NB * SEQ, MS = DB * DS, M = MP + MS;
constexpr int FF = 5632, F2 = 2 * FF, PLE = 256;
constexpr int RH = 8, DK = 256, DV = 512, NPROJ = 12288;
constexpr int PBUF = 15, PAST = 16384, NPOS = SEQ + DS;
constexpr float EPS = 1e-6f;
constexpr int NWAVES = 8, NT = NWAVES * 64;

constexpr size_t O_YP = 0, O_YS = (size_t)MP * D, O_PP = O_YS + (size_t)MS * D, O_PS = O_PP + (size_t)NB * PBUF * D,
                 O_RP = O_PS + (size_t)DB * PBUF * D, O_RS = O_RP + (size_t)NB * RH * DK * DV, O_CP = O_RS + (size_t)DB * RH * DK * DV,
                 O_CS = O_CP + (size_t)2 * NB * 2 * F2, O_END = O_CS + (size_t)2 * DB * 2 * F2;

constexpr size_t MiB = 1u << 20;
constexpr size_t WS_CTL = 0, CTL_ZERO_BYTES = 1 * MiB;
constexpr size_t WS_ROPE = 2 * MiB;
constexpr size_t WS_SSQV = 65536, SSQV_STRIDE = 36864;
constexpr size_t WS_WPOOL = 16 * MiB;
constexpr size_t WS_WP = 18 * MiB;
constexpr size_t WS_WG = 20 * MiB;
constexpr size_t WS_WUP = 36 * MiB;
constexpr size_t WS_WDN = 124 * MiB;
constexpr size_t WS_WIN = 168 * MiB;
constexpr size_t WS_WOUT = 216 * MiB;
constexpr size_t WS_PB = 240 * MiB;
constexpr size_t WS_DPRE = 250 * MiB;
constexpr size_t WS_EMB0 = 284 * MiB, WS_EMB1 = 318 * MiB;
constexpr size_t WS_XSA = 352 * MiB, WS_XSB = 420 * MiB;
constexpr size_t WS_XB0 = 488 * MiB, WS_XB1 = 522 * MiB;
constexpr size_t WS_U = 560 * MiB;
constexpr size_t WS_UBND = 560 * MiB;
constexpr size_t WS_ACT = 748 * MiB;
constexpr size_t WS_PROJ = 842 * MiB;
constexpr size_t WS_OB = 1046 * MiB;
constexpr size_t WS_END = 1114 * MiB;
static_assert(WS_WPOOL + (size_t)2048 * 512 * 2 <= WS_WP && WS_WP + (size_t)2 * 2048 * 256 * 2 <= WS_WG && WS_WG + (size_t)2 * 2048 * 2048 * 2 <= WS_WUP &&
              WS_WUP + (size_t)2 * F2 * D * 2 <= WS_WDN && WS_WDN + (size_t)2 * D * FF * 2 <= WS_WIN && WS_WIN + (size_t)NPROJ * D * 2 <= WS_WOUT && WS_WOUT + (size_t)D * 4096 * 2 <= WS_PB, "ws weights");
static_assert(WS_PB + (size_t)2 * M * PLE * 2 <= WS_DPRE && WS_DPRE + (size_t)M * D * 2 <= WS_EMB0 && WS_EMB0 + (size_t)M * D * 2 <= WS_EMB1 && WS_EMB1 + (size_t)M * D * 2 <= WS_XSA &&
              WS_XSA + (size_t)M * D * 4 <= WS_XSB && WS_XSB + (size_t)M * D * 4 <= WS_XB0 && WS_XB0 + (size_t)M * D * 2 <= WS_XB1 && WS_XB1 + (size_t)M * D * 2 <= WS_U &&
              WS_U + (size_t)M * F2 * 2 <= WS_ACT && WS_ACT + (size_t)M * FF * 2 <= WS_PROJ && WS_PROJ + (size_t)M * NPROJ * 2 <= WS_OB && WS_OB + (size_t)M * 4096 * 2 <= WS_END, "ws activations");
static_assert(WS_ROPE + (size_t)2 * NPOS * 128 * 4 <= WS_WPOOL && WS_SSQV + 7 * SSQV_STRIDE <= CTL_ZERO_BYTES && (size_t)M * 4 <= SSQV_STRIDE, "ws tables");
constexpr int CW_BAR = 4096, CW_PCNT = 8192;

constexpr int RING_BYTES = 131072, XA_BYTES = 4096, LDSCTL_OFF = RING_BYTES + XA_BYTES, MISC_OFF = LDSCTL_OFF + 320, XCH_OFF = LDSCTL_OFF + 1024, XCH_BYTES = 8192, LDS_BYTES = 147456;

__device__ __forceinline__ unsigned f2bf(float f) { unsigned u = __builtin_bit_cast(unsigned, f); return (u + 0x7fffu + ((u >> 16) & 1u)) >> 16; }
__device__ __forceinline__ unsigned pk2(float lo, float hi) { unsigned r; asm("v_cvt_pk_bf16_f32 %0, %1, %2" : "=v"(r) : "v"(lo), "v"(hi)); return r; }
__device__ __forceinline__ float bflo(unsigned w) { return __builtin_bit_cast(float, w << 16); }
__device__ __forceinline__ float bfhi(unsigned w) { return __builtin_bit_cast(float, w & 0xffff0000u); }
__device__ __forceinline__ float wave_sum(float v) {
#pragma unroll
    for (int o = 1; o < 64; o <<= 1) v += __shfl_xor(v, o);
    return v;
}
__device__ __forceinline__ float fq_reduce(float ss) {
    int l = (int)__builtin_amdgcn_mbcnt_hi(~0u, __builtin_amdgcn_mbcnt_lo(~0u, 0u)); asm volatile("" : "+v"(l));
    ss += __int_as_float(__builtin_amdgcn_ds_bpermute((l ^ 16) << 2, __float_as_int(ss)));
    ss += __int_as_float(__builtin_amdgcn_ds_bpermute((l ^ 32) << 2, __float_as_int(ss)));
    return ss;
}
__device__ __forceinline__ float gamma_l2(int h) {
    float v = -4.580368961e-02f;
    v = (h == 1) ? -2.272007650e-02f : v; v = (h == 2) ? -1.131531323e-02f : v; v = (h == 3) ? -5.646563141e-03f : v; v = (h == 4) ? -2.820519062e-03f : v;
    v = (h == 5) ? -1.409570255e-03f : v; v = (h == 6) ? -7.046129766e-04f : v; v = (h == 7) ? -3.522634716e-04f : v;
    return v;
}
__device__ __forceinline__ float silu_f(float x) { return x * __builtin_amdgcn_rcpf(1.f + __expf(-x)); }
__device__ __forceinline__ float sigmoid_f(float x) { return __builtin_amdgcn_rcpf(1.f + __expf(-x)); }
__device__ __forceinline__ float row_rstd(const float* ssq, int row) { return __builtin_amdgcn_rsqf(ssq[row] * (1.f / D) + EPS); }

namespace pg8 {
constexpr int BM = 256, BK = 64, HALF = 128, HTB = HALF * BK * 2, STAGE_BYTES = 8 * HTB, NXCD = 8, WGM = 8;
__host__ __device__ __forceinline__ int lds_byte(int r, int c) { const int st = (r >> 4) * 2 + (c >> 5), rr = r & 15, cc = c & 31, ob = rr * 64 + cc * 2; return st * 1024 + (ob ^ (((ob >> 9) & 1) << 5)); }
__host__ __device__ __forceinline__ void stage_rc(int b, int& R, int& C) { const int st = b / 1024, sb = b % 1024, swz = sb ^ (((sb >> 9) & 1) << 5); R = (st >> 1) * 16 + swz / 64; C = (st & 1) * 32 + (swz % 64) / 2; }
__host__ __device__ __forceinline__ int perm32(int rho) { const int n = rho >> 4, i = rho & 15; return 8 * (i >> 2) + 4 * n + (i & 3); }
struct Unit { int pm, pn; };
struct Gemm { const bf16* A; const bf16* Bt; int lda, K, grp; };
struct StaticOrder {
    int nM, nN, nwg, G, c;
    __host__ __device__ __forceinline__ void init(int M_, int N_, int G_, int c_) { nM = M_ / BM; nN = N_ / BM; nwg = nM * nN; G = G_; c = c_; }
    __host__ __device__ __forceinline__ bool next(int i, Unit& u) const {
        if (c < 0) return false;
        const long L = (long)i * G + c; if (L >= nwg) return false;
        int wgid = (int)L; { const int q = nwg / NXCD, r = nwg % NXCD, xcd = wgid % NXCD, off = wgid / NXCD; wgid = (xcd < r ? xcd * (q + 1) : r * (q + 1) + (xcd - r) * q) + off; }
        const int nig = WGM * nN, gid = wgid / nig, fm = gid * WGM, gsz = (nM - fm) < WGM ? (nM - fm) : WGM;
        u.pm = fm + ((wgid % nig) % gsz); u.pn = (wgid % nig) / gsz; return true;
    }
};
template <class Epi, bool XT, int VAR = 0>
__device__ __forceinline__ void gemm_phase(LAS unsigned char* lds, const Gemm g, const StaticOrder& S, const Epi& E, int wave_s) {
    const int wid = __builtin_amdgcn_readfirstlane(wave_s); int lane = (int)__builtin_amdgcn_mbcnt_hi(~0u, __builtin_amdgcn_mbcnt_lo(~0u, 0u)); asm volatile("" : "+v"(lane));
    const int tid = wid * 64 + lane, wr = wid >> 2, wc = wid & 3, fr = lane & 15, fq = lane >> 4;
    int K = g.K, lda = g.lda; asm volatile("" : "+s"(K), "+s"(lda));
    const int nt = K / BK;
    unsigned voffA[2], voffB[2], voffX = 0;
#pragma unroll
    for (int i = 0; i < 2; ++i) { int R, C; stage_rc(tid * 16 + i * 8192, R, C); const int Rb = (R & ~31) + perm32(R & 31);
        voffA[i] = (unsigned)(R * lda + C) * 2u; voffB[i] = (unsigned)(Rb * K + C) * 2u; }
    if (XT) { int R, C; stage_rc(wid * 256 + fr * 16, R, C); voffX = (unsigned)(R * lda + C) * 2u; }
    const unsigned kstep = (unsigned)(BK * 2);
    const unsigned hA = (unsigned)HALF * lda * 2, hB = (unsigned)HALF * K * 2, tA = 2 * hA, tB = 2 * hB, tX = (unsigned)16 * lda * 2, xbase = (unsigned)MP * lda * 2;
    const __amdgpu_buffer_rsrc_t rsA = __builtin_amdgcn_make_buffer_rsrc((void*)g.A, 0, 0xFFFFFFF0u, 0x00020000), rsB = __builtin_amdgcn_make_buffer_rsrc((void*)g.Bt, 0, 0xFFFFFFF0u, 0x00020000);
    const unsigned ldsw = (unsigned)wid * 1024u;
    const int aoff = lds_byte(wr * 64 + fr, fq * 8), boff = lds_byte(wc * 32 + fr, fq * 8), xoff = lds_byte(fr, fq * 8);
#define PG8_SA(b, h) (((b) * 2 + (h)) * HTB)
#define PG8_SB(b, h) ((4 + (b) * 2 + (h)) * HTB)
#define PG8_XA(b) (STAGE_BYTES + (b) * 2048)
#define PG8_STAGE(bufoff, rs, soff, voff) do { if constexpr (VAR != 3) _Pragma("unroll") for (int _i = 0; _i < 2; ++_i) \
        __builtin_amdgcn_raw_ptr_buffer_load_lds(rs, (LAS unsigned*)(lds + (bufoff) + ldsw + _i * 8192), 16, (voff)[_i], (soff), 0, 0); } while (0)
#define PG8_STAGEX(b, soff) do { if constexpr (XT) { if (lane < 16) \
        __builtin_amdgcn_raw_ptr_buffer_load_lds(rsA, (LAS unsigned*)(lds + PG8_XA(b) + wid * 256), 16, voffX, (soff), 0, 0); } } while (0)
#define PG8_LDA(dst, b, h) do { if constexpr (VAR != 1) _Pragma("unroll") for (int m = 0; m < 4; ++m) _Pragma("unroll") for (int k = 0; k < 2; ++k) dst[m][k] = *(const LAS bf16x8*)(lds + PG8_SA(b, h) + aoff + m * 2048 + k * 1024); } while (0)
#define PG8_LDB(dst, b, h) do { if constexpr (VAR != 1) _Pragma("unroll") for (int n = 0; n < 2; ++n) _Pragma("unroll") for (int k = 0; k < 2; ++k) dst[n][k] = *(const LAS bf16x8*)(lds + PG8_SB(b, h) + boff + n * 2048 + k * 1024); } while (0)
#define PG8_LDX(b) do { if constexpr (XT) { _Pragma("unroll") for (int k = 0; k < 2; ++k) Ax[k] = *(const LAS bf16x8*)(lds + PG8_XA(b) + xoff + k * 1024); } } while (0)
#define PG8_MMA(ai, bj, At, Bt) do { if constexpr (VAR < 4 || VAR == 9) __builtin_amdgcn_s_setprio(1); \
        if constexpr (VAR == 9) { _Pragma("unroll") for (int m = 0; m < 4; ++m) _Pragma("unroll") for (int k = 0; k < 2; ++k) acc32[ai][bj][m >> 1] = __builtin_amdgcn_mfma_f32_32x32x16_bf16(Bt[m & 1][k], At[m][k], acc32[ai][bj][m >> 1], 0, 0, 0); } \
        else if constexpr (VAR != 2) _Pragma("unroll") for (int m = 0; m < 4; ++m) _Pragma("unroll") for (int n = 0; n < 2; ++n) _Pragma("unroll") for (int k = 0; k < 2; ++k) \
        acc[ai][bj][m][n] = __builtin_amdgcn_mfma_f32_16x16x32_bf16(Bt[n][k], At[m][k], acc[ai][bj][m][n], 0, 0, 0); if constexpr (VAR < 4 || VAR == 9) __builtin_amdgcn_s_setprio(0); } while (0)
#define PG8_MMAX() do { if constexpr (XT) { if (wr == 0) { _Pragma("unroll") for (int k = 0; k < 2; ++k) { accx[0] = __builtin_amdgcn_mfma_f32_16x16x32_bf16(B0[0][k], Ax[k], accx[0], 0, 0, 0); accx[1] = __builtin_amdgcn_mfma_f32_16x16x32_bf16(B1[0][k], Ax[k], accx[1], 0, 0, 0); } } \
        else { _Pragma("unroll") for (int k = 0; k < 2; ++k) { accx[0] = __builtin_amdgcn_mfma_f32_16x16x32_bf16(B0[1][k], Ax[k], accx[0], 0, 0, 0); accx[1] = __builtin_amdgcn_mfma_f32_16x16x32_bf16(B1[1][k], Ax[k], accx[1], 0, 0, 0); } } } } while (0)
#define PG8_WAIT_V(n) asm volatile("s_waitcnt vmcnt(" #n ")" ::: "memory")
#define PG8_WAIT_VL() do { if constexpr (XT) PG8_WAIT_V(9); else PG8_WAIT_V(8); } while (0)
#define PG8_WAIT_L(n) asm volatile("s_waitcnt lgkmcnt(" #n ")" ::: "memory")
#define PG8_BAR __builtin_amdgcn_s_barrier()
#define PG8_SCHED __builtin_amdgcn_sched_barrier(0)
    Unit cur, nxt; int ui = 0;
    if (!S.next(0, cur)) return;
    if constexpr (VAR == 5) { if (wr == 1) __builtin_amdgcn_s_setprio(1); }
    f32x4 acc[2][2][4][2]; f32x4 accx[2];
    typedef float f32x16 __attribute__((ext_vector_type(16)));
    f32x16 acc32[2][2][2];
    if constexpr (VAR == 9) { _Pragma("unroll") for (int a_ = 0; a_ < 2; ++a_) _Pragma("unroll") for (int b_ = 0; b_ < 2; ++b_) _Pragma("unroll") for (int c_ = 0; c_ < 2; ++c_) _Pragma("unroll") for (int e_ = 0; e_ < 16; ++e_) acc32[a_][b_][c_][e_] = 0.f; }
#pragma unroll
    for (int a = 0; a < 2; ++a)
#pragma unroll
        for (int b = 0; b < 2; ++b)
#pragma unroll
            for (int m = 0; m < 4; ++m)
#pragma unroll
                for (int n = 0; n < 2; ++n) acc[a][b][m][n] = (f32x4){0.f, 0.f, 0.f, 0.f};
    accx[0] = (f32x4){0.f, 0.f, 0.f, 0.f}; accx[1] = (f32x4){0.f, 0.f, 0.f, 0.f};
    bf16x8 At[4][2], B0[2][2], B1[2][2], Ax[2];
    if constexpr (VAR == 1) { const bf16x8 z_ = (bf16x8){(short)lane, 1, 2, 3, 4, 5, 6, 7};
        _Pragma("unroll") for (int m = 0; m < 4; ++m) { At[m][0] = z_; At[m][1] = z_; } _Pragma("unroll") for (int n = 0; n < 2; ++n) { B0[n][0] = z_; B0[n][1] = z_; B1[n][0] = z_; B1[n][1] = z_; } }
    const unsigned acol0 = g.grp ? (unsigned)(cur.pn / g.grp) * K * 2 : 0u;
    unsigned cA = (unsigned)cur.pm * tA + acol0, cB = (unsigned)cur.pn * tB, cX = xbase + (unsigned)cur.pm * tX + acol0;
    PG8_STAGE(PG8_SB(0, 0), rsB, cB, voffB); PG8_STAGE(PG8_SB(0, 1), rsB, cB + hB, voffB); PG8_STAGE(PG8_SA(0, 0), rsA, cA, voffA); PG8_STAGEX(0, cX); PG8_STAGE(PG8_SA(0, 1), rsA, cA + hA, voffA);
    if (wr == 1) PG8_BAR;
    PG8_WAIT_V(2); PG8_BAR;
    PG8_STAGE(PG8_SB(1, 0), rsB, cB + kstep, voffB); PG8_STAGE(PG8_SA(1, 0), rsA, cA + kstep, voffA); PG8_STAGE(PG8_SB(1, 1), rsB, cB + hB + kstep, voffB); PG8_STAGEX(1, cX + kstep);
    if constexpr (XT) PG8_WAIT_V(7); else PG8_WAIT_V(6);
    PG8_BAR;
    for (;;) {
        const bool has_next = S.next(ui + 1, nxt);
        const unsigned acoln = (has_next && g.grp) ? (unsigned)(nxt.pn / g.grp) * K * 2 : 0u;
        const unsigned nA = has_next ? (unsigned)nxt.pm * tA + acoln : cA;
        const unsigned nB = has_next ? (unsigned)nxt.pn * tB : cB;
        const unsigned nX = has_next ? xbase + (unsigned)nxt.pm * tX + acoln : cX;
        for (int t = 0; t < nt; t += 2) {
            const bool last = (t == nt - 2);
            const unsigned a1 = cA + (unsigned)(t + 1) * kstep;
            const unsigned a2 = last ? nA : cA + (unsigned)(t + 2) * kstep, b2 = last ? nB : cB + (unsigned)(t + 2) * kstep, x2 = last ? nX : cX + (unsigned)(t + 2) * kstep;
            const unsigned a3 = a2 + kstep, b3 = b2 + kstep, x3 = x2 + kstep;
            PG8_LDB(B0, 0, 0); PG8_LDB(B1, 0, 1); PG8_SCHED; PG8_LDA(At, 0, 0); PG8_LDX(0); PG8_STAGE(PG8_SA(1, 1), rsA, a1 + hA, voffA);
            PG8_WAIT_VL(); PG8_WAIT_L(0); PG8_BAR; PG8_MMA(0, 0, At, B0); PG8_MMA(0, 1, At, B1); PG8_MMAX(); PG8_BAR; PG8_SCHED;
            PG8_LDA(At, 0, 1); PG8_STAGE(PG8_SB(0, 0), rsB, b2, voffB); PG8_STAGE(PG8_SB(0, 1), rsB, b2 + hB, voffB); PG8_STAGE(PG8_SA(0, 0), rsA, a2, voffA); PG8_STAGEX(0, x2);
            PG8_WAIT_VL(); PG8_WAIT_L(0); PG8_BAR; PG8_MMA(1, 0, At, B0); PG8_MMA(1, 1, At, B1); PG8_BAR; PG8_SCHED;
            PG8_LDB(B0, 1, 0); PG8_LDB(B1, 1, 1); PG8_SCHED; PG8_LDA(At, 1, 0); PG8_LDX(1); PG8_STAGE(PG8_SA(0, 1), rsA, a2 + hA, voffA);
            PG8_WAIT_VL(); PG8_WAIT_L(0); PG8_BAR; PG8_MMA(0, 0, At, B0); PG8_MMA(0, 1, At, B1); PG8_MMAX(); PG8_BAR; PG8_SCHED;
            PG8_LDA(At, 1, 1); PG8_STAGE(PG8_SB(1, 0), rsB, b3, voffB); PG8_STAGE(PG8_SB(1, 1), rsB, b3 + hB, voffB); PG8_STAGE(PG8_SA(1, 0), rsA, a3, voffA); PG8_STAGEX(1, x3);
            PG8_WAIT_VL(); PG8_WAIT_L(0); PG8_BAR; PG8_MMA(1, 0, At, B0); PG8_MMA(1, 1, At, B1); PG8_BAR; PG8_SCHED;
        }
        if (wr == 0) PG8_BAR;
        if constexpr (VAR == 9) { _Pragma("unroll") for (int a_ = 0; a_ < 2; ++a_) _Pragma("unroll") for (int b_ = 0; b_ < 2; ++b_) _Pragma("unroll") for (int c_ = 0; c_ < 2; ++c_) _Pragma("unroll") for (int e_ = 0; e_ < 16; ++e_) { acc[a_][b_][2 * c_ + (e_ >> 3)][(e_ >> 2) & 1][e_ & 3] = acc32[a_][b_][c_][e_]; acc32[a_][b_][c_][e_] = 0.f; } }
        E.template run<XT>(acc, accx, cur, wr, wc, fr, fq);
        if constexpr (Epi::FIN) E.finish(acc, accx, cur, wr, wc, fr, fq, wid);
        if (!has_next) break;
#pragma unroll
        for (int a = 0; a < 2; ++a)
#pragma unroll
            for (int b = 0; b < 2; ++b)
#pragma unroll
                for (int m = 0; m < 4; ++m)
#pragma unroll
                    for (int n = 0; n < 2; ++n) acc[a][b][m][n] = (f32x4){0.f, 0.f, 0.f, 0.f};
        accx[0] = (f32x4){0.f, 0.f, 0.f, 0.f}; accx[1] = (f32x4){0.f, 0.f, 0.f, 0.f};
        cur = nxt; cA = nA; cB = nB; cX = nX; ++ui;
        if (wr == 1) PG8_BAR;
    }
    PG8_WAIT_V(0);
    PG8_BAR;
    if constexpr (VAR == 5) __builtin_amdgcn_s_setprio(0);
#undef PG8_SA
#undef PG8_SB
#undef PG8_XA
#undef PG8_STAGE
#undef PG8_STAGEX
#undef PG8_LDA
#undef PG8_LDB
#undef PG8_LDX
#undef PG8_MMA
#undef PG8_MMAX
#undef PG8_WAIT_V
#undef PG8_WAIT_VL
#undef PG8_WAIT_L
#undef PG8_BAR
#undef PG8_SCHED
}

typedef f32x4 Acc[2][2][4][2];
template <int NV> struct PackT;
template <> struct PackT<2> { typedef u32x4 T; static __device__ __forceinline__ T pack(const f32x4* v) { T w; w.x = pk2(v[0][0], v[0][1]); w.y = pk2(v[0][2], v[0][3]); w.z = pk2(v[1][0], v[1][1]); w.w = pk2(v[1][2], v[1][3]); return w; }
    static __device__ __forceinline__ void unpack(T w, f32x4* v) { v[0] = (f32x4){bflo(w.x), bfhi(w.x), bflo(w.y), bfhi(w.y)}; v[1] = (f32x4){bflo(w.z), bfhi(w.z), bflo(w.w), bfhi(w.w)}; } };
template <> struct PackT<1> { typedef u32x2 T; static __device__ __forceinline__ T pack(const f32x4* v) { T w; w.x = pk2(v[0][0], v[0][1]); w.y = pk2(v[0][2], v[0][3]); return w; }
    static __device__ __forceinline__ void unpack(T w, f32x4* v) { v[0] = (f32x4){bflo(w.x), bfhi(w.x), bflo(w.y), bfhi(w.y)}; } };
template <int NV> __device__ __forceinline__ float sumsq(const f32x4* v) { float s = 0.f;
#pragma unroll
    for (int n = 0; n < NV; ++n) s += (v[n][0] * v[n][0] + v[n][1] * v[n][1]) + (v[n][2] * v[n][2] + v[n][3] * v[n][3]);
    return s; }

template <class T> __device__ __forceinline__ T ldg(const void* base, unsigned byteoff) { return *(const T*)((const char*)base + (size_t)byteoff); }
template <class T> __device__ __forceinline__ void stg(void* base, unsigned byteoff, T v) { *(T*)((char*)base + (size_t)byteoff) = v; }
template <class Epi> struct EpiDrive : Epi {
    static constexpr bool FIN = false;
    __device__ __forceinline__ EpiDrive(const Epi& e) : Epi(e) {}
    template <bool XT> __device__ __forceinline__ void run(const Acc& acc, const f32x4 (&accx)[2], const Unit& u, int wr, int wc, int fr, int fq) const {
        asm volatile("" : "+v"(fr), "+v"(fq));
        const int row0 = u.pm * BM + wr * 64 + fr, cseg = wc * 32 + 8 * fq; const bool smp = u.pm >= MP / BM;
        const int rowx = MP + 16 * u.pm + fr, csegx = cseg + 4 * wr;
        float rsv[2][4], rsx = 0.f, ssv[2][4], ssx = 0.f;
        if (Epi::RSTD) {
#pragma unroll
            for (int ai = 0; ai < 2; ++ai)
#pragma unroll
                for (int m = 0; m < 4; ++m) rsv[ai][m] = ldg<float>(this->ssq_in, (unsigned)(row0 + ai * HALF + m * 16) * 4u);
            if (XT) rsx = ldg<float>(this->ssq_in, (unsigned)rowx * 4u); }
        if constexpr (Epi::PRE > 0) {
            f32x4 bufx[Epi::PRE];
            if constexpr (XT) this->template pre<1>(rowx, csegx, u.pn, true, bufx);
#pragma unroll
            for (int ai = 0; ai < 2; ++ai)
#pragma unroll
              for (int mb = 0; mb < 4; mb += Epi::PB) { f32x4 buf[Epi::PB][Epi::PRE];
#pragma unroll
                for (int m = 0; m < Epi::PB; ++m) this->template pre<2>(row0 + ai * HALF + (mb + m) * 16, cseg, u.pn, smp, buf[m]);
#pragma unroll
                for (int m = 0; m < Epi::PB; ++m) { const float rs = Epi::RSTD ? __builtin_amdgcn_rsqf(rsv[ai][mb + m] * (1.f / D) + EPS) : 1.f;
                    ssv[ai][mb + m] = this->template seg<2>(row0 + ai * HALF + (mb + m) * 16, cseg, u.pn, acc[ai][0][mb + m], acc[ai][1][mb + m], rs, smp, buf[m]); } }
            if constexpr (XT) ssx = this->template seg<1>(rowx, csegx, u.pn, &accx[0], &accx[1], Epi::RSTD ? __builtin_amdgcn_rsqf(rsx * (1.f / D) + EPS) : 1.f, true, bufx);
        } else {
#pragma unroll
            for (int ai = 0; ai < 2; ++ai)
#pragma unroll
                for (int m = 0; m < 4; ++m) { const float rs = Epi::RSTD ? __builtin_amdgcn_rsqf(rsv[ai][m] * (1.f / D) + EPS) : 1.f;
                    ssv[ai][m] = this->template seg<2>(row0 + ai * HALF + m * 16, cseg, u.pn, acc[ai][0][m], acc[ai][1][m], rs, smp, nullptr); }
            if constexpr (XT) ssx = this->template seg<1>(rowx, csegx, u.pn, &accx[0], &accx[1], Epi::RSTD ? __builtin_amdgcn_rsqf(rsx * (1.f / D) + EPS) : 1.f, true, nullptr);
        }
        if constexpr (Epi::SSQ) { if (fq == 0) {
#pragma unroll
            for (int ai = 0; ai < 2; ++ai)
#pragma unroll
                for (int m = 0; m < 4; ++m) unsafeAtomicAdd(this->ssq_out + row0 + ai * HALF + m * 16, ssv[ai][m]);
            if (XT) unsafeAtomicAdd(this->ssq_out + rowx, ssx); } }
    }
};

struct EpiBf16 {
    static constexpr bool RSTD = false, SSQ = false; static constexpr int PRE = 0, PB = 1;
    bf16* O; const float* ssq_in;
    template <int NV> __device__ __forceinline__ float seg(int row, int cseg, int pn, const f32x4* v0, const f32x4* v1, float, bool, const f32x4*) const {
        const unsigned ob = (unsigned)(row * D + pn * BM + cseg) * 2u;
        stg(O, ob, PackT<NV>::pack(v0)); stg(O, ob + HALF * 2, PackT<NV>::pack(v1)); return 0.f;
    }
};

struct EpiRes {
    static constexpr bool RSTD = false, SSQ = true; static constexpr int PRE = 4, PB = 4;
    const float* xinP; const float* xinS; const bf16* xbin;
    bf16* xb; float* ssq_out; const float* colscale; const float* ssq_in;
    template <int NV> __device__ __forceinline__ void pre(int row, int cseg, int pn, bool smp, f32x4* buf) const {
        const unsigned oe = (unsigned)(row * D + pn * BM + cseg);
        if (xbin) {
#pragma unroll
            for (int bj = 0; bj < 2; ++bj) {
                if (NV == 2) buf[bj] = __builtin_bit_cast(f32x4, ldg<u32x4>(xbin, (oe + bj * HALF) * 2u));
                else { const u32x2 e2 = ldg<u32x2>(xbin, (oe + bj * HALF) * 2u); buf[bj] = __builtin_bit_cast(f32x4, (u32x4){e2.x, e2.y, 0u, 0u}); } }
        } else {
            const float* xin = smp ? xinS - (size_t)MP * D : xinP;
#pragma unroll
            for (int bj = 0; bj < 2; ++bj)
#pragma unroll
                for (int n = 0; n < NV; ++n) buf[bj * 2 + n] = ldg<f32x4>(xin, (oe + bj * HALF + 4 * n) * 4u);
        }
    }
    template <int NV> __device__ __forceinline__ float seg(int row, int cseg, int pn, const f32x4* v0, const f32x4* v1, float, bool, const f32x4* buf) const {
        const unsigned oe = (unsigned)(row * D + pn * BM + cseg);
        float ss = 0.f;
#pragma unroll
        for (int bj = 0; bj < 2; ++bj) { const f32x4* v = bj ? v1 : v0; f32x4 r[NV], x[2];
            if (xbin) { const u32x4 w = __builtin_bit_cast(u32x4, buf[bj]); x[0] = (f32x4){bflo(w.x), bfhi(w.x), bflo(w.y), bfhi(w.y)}; x[1] = (f32x4){bflo(w.z), bfhi(w.z), bflo(w.w), bfhi(w.w)}; }
            else { x[0] = buf[bj * 2]; x[1] = buf[bj * 2 + 1]; }
#pragma unroll
            for (int n = 0; n < NV; ++n) { f32x4 a = v[n]; if (colscale) a = a * ldg<f32x4>(colscale, (unsigned)(pn * BM + cseg + bj * HALF + 4 * n) * 4u);
                r[n] = x[n] + a; }
            stg(xb, (oe + bj * HALF) * 2u, PackT<NV>::pack(r)); ss += sumsq<NV>(r); }
        ss = fq_reduce(ss);
        return ss;
    }
};

struct EpiUp {
    static constexpr bool RSTD = true, SSQ = false; static constexpr int PRE = 0, PB = 1;
    bf16* U; const float* ssq_in; float* convP; float* convS;
    template <int NV> __device__ __forceinline__ float seg(int row, int cseg, int pn, const f32x4* v0, const f32x4* v1, float rs, bool smp, const f32x4*) const {
        float* cbase = smp ? convS : convP;
        int crow = -1;
        if (!smp) { const int t = row & (SEQ - 1); if (t >= SEQ - 2) crow = (row >> 11) * 2 + (t - (SEQ - 2)); }
        else { const int s_ = row - MP, t = s_ & 3; if (t >= 2) crow = (s_ >> 2) * 2 + (t - 2); }
        const unsigned ub = (unsigned)(row * F2 + pn * BM + cseg) * 2u;
#pragma unroll
        for (int bj = 0; bj < 2; ++bj) { const f32x4* v = bj ? v1 : v0; f32x4 r[NV];
#pragma unroll
            for (int n = 0; n < NV; ++n) r[n] = v[n] * rs;
            stg(U, ub + bj * HALF * 2, PackT<NV>::pack(r));
            if (crow >= 0) {
#pragma unroll
                for (int n = 0; n < NV; ++n) stg(cbase, (unsigned)(crow * F2 + bj * FF + pn * HALF + cseg + 4 * n) * 4u, r[n]); } }
        return 0.f;
    }
};

struct EpiPle {
    static constexpr bool RSTD = true, SSQ = true; static constexpr int PRE = 4, PB = 4;
    const bf16* xbin; const bf16* emb; const float* ssq_in; bf16* xb; float* ssq_out;
    template <int NV> __device__ __forceinline__ void pre(int row, int cseg, int pn, bool, f32x4* buf) const {
        const unsigned oe = (unsigned)(row * D + pn * BM + cseg);
#pragma unroll
        for (int bj = 0; bj < 2; ++bj) {
            if (NV == 2) { buf[bj] = __builtin_bit_cast(f32x4, ldg<u32x4>(xbin, (oe + bj * HALF) * 2u)); buf[2 + bj] = __builtin_bit_cast(f32x4, ldg<u32x4>(emb, (oe + bj * HALF) * 2u)); }
            else { const u32x2 x2 = ldg<u32x2>(xbin, (oe + bj * HALF) * 2u), e2 = ldg<u32x2>(emb, (oe + bj * HALF) * 2u);
                buf[bj] = __builtin_bit_cast(f32x4, (u32x4){x2.x, x2.y, 0u, 0u}); buf[2 + bj] = __builtin_bit_cast(f32x4, (u32x4){e2.x, e2.y, 0u, 0u}); } }
    }
    template <int NV> __device__ __forceinline__ float seg(int row, int cseg, int pn, const f32x4* v0, const f32x4* v1, float rs, bool, const f32x4* buf) const {
        const unsigned oe = (unsigned)(row * D + pn * BM + cseg);
        float ss = 0.f;
#pragma unroll
        for (int bj = 0; bj < 2; ++bj) { const f32x4* v = bj ? v1 : v0; f32x4 r[NV], e[2], x[2];
            const u32x4 xw = __builtin_bit_cast(u32x4, buf[bj]), ew = __builtin_bit_cast(u32x4, buf[2 + bj]);
            x[0] = (f32x4){bflo(xw.x), bfhi(xw.x), bflo(xw.y), bfhi(xw.y)}; x[1] = (f32x4){bflo(xw.z), bfhi(xw.z), bflo(xw.w), bfhi(xw.w)};
            e[0] = (f32x4){bflo(ew.x), bfhi(ew.x), bflo(ew.y), bfhi(ew.y)}; e[1] = (f32x4){bflo(ew.z), bfhi(ew.z), bflo(ew.w), bfhi(ew.w)};
#pragma unroll
            for (int n = 0; n < NV; ++n) { const f32x4 a = v[n] * rs;
#pragma unroll
                for (int k = 0; k < 4; ++k) r[n][k] = x[n][k] + sigmoid_f(a[k]) * e[n][k]; }
            stg(xb, (oe + bj * HALF) * 2u, PackT<NV>::pack(r)); ss += sumsq<NV>(r); }
        ss = fq_reduce(ss);
        return ss;
    }
};

struct EpiPleFin {
    static constexpr bool FIN = true;
    const bf16* xin; const bf16* emb; const float* ssq_in; float* ssq_out; const float* gfin; float* out; unsigned* pcnt; unsigned* tmo;
    template <int NV> struct In { typename PackT<NV>::T x[2], e[2]; };
    template <int NV> __device__ __forceinline__ void load(int row, int cseg, int pn, In<NV>& in) const {
        const unsigned oe = (unsigned)(row * D + pn * BM + cseg);
#pragma unroll
        for (int bj = 0; bj < 2; ++bj) { in.x[bj] = ldg<typename PackT<NV>::T>(xin, (oe + bj * HALF) * 2u); in.e[bj] = ldg<typename PackT<NV>::T>(emb, (oe + bj * HALF) * 2u); }
    }
    template <int NV> __device__ __forceinline__ float row(const In<NV>& in, f32x4* v0, f32x4* v1, float rs) const {
        float ss = 0.f;
#pragma unroll
        for (int bj = 0; bj < 2; ++bj) { f32x4* v = bj ? v1 : v0; f32x4 e[NV], x[NV]; PackT<NV>::unpack(in.e[bj], e); PackT<NV>::unpack(in.x[bj], x);
#pragma unroll
            for (int n = 0; n < NV; ++n) { const f32x4 a = v[n] * rs; f32x4 r;
#pragma unroll
                for (int k = 0; k < 4; ++k) r[k] = x[n][k] + sigmoid_f(a[k]) * e[n][k];
                v[n] = r; ss += (r[0] * r[0] + r[1] * r[1]) + (r[2] * r[2] + r[3] * r[3]); } }
        ss = fq_reduce(ss);
        return ss;
    }
    template <bool XT> __device__ __forceinline__ void run(Acc& acc, f32x4 (&accx)[2], const Unit& u, int wr, int wc, int fr, int fq) const {
        asm volatile("" : "+v"(fr), "+v"(fq));
        const int row0 = u.pm * BM + wr * 64 + fr, cseg = wc * 32 + 8 * fq, rowx = MP + 16 * u.pm + fr, csegx = cseg + 4 * wr;
        float rsv[2][4], ssv[2][4];
#pragma unroll
        for (int ai = 0; ai < 2; ++ai)
#pragma unroll
            for (int m = 0; m < 4; ++m) rsv[ai][m] = ldg<float>(ssq_in, (unsigned)(row0 + ai * HALF + m * 16) * 4u);
        const float rsx = ldg<float>(ssq_in, (unsigned)rowx * 4u);
        In<1> inx; load<1>(rowx, csegx, u.pn, inx);
#pragma unroll
        for (int ai = 0; ai < 2; ++ai) { In<2> in[4];
#pragma unroll
            for (int m = 0; m < 4; ++m) load<2>(row0 + ai * HALF + m * 16, cseg, u.pn, in[m]);
#pragma unroll
            for (int m = 0; m < 4; ++m) ssv[ai][m] = row<2>(in[m], acc[ai][0][m], acc[ai][1][m], __builtin_amdgcn_rsqf(rsv[ai][m] * (1.f / D) + EPS)); }
        const float ssx = row<1>(inx, &accx[0], &accx[1], __builtin_amdgcn_rsqf(rsx * (1.f / D) + EPS));
        if (fq == 0) {
#pragma unroll
            for (int ai = 0; ai < 2; ++ai)
#pragma unroll
                for (int m = 0; m < 4; ++m) unsafeAtomicAdd(ssq_out + row0 + ai * HALF + m * 16, ssv[ai][m]);
            unsafeAtomicAdd(ssq_out + rowx, ssx); }
    }
    __device__ __forceinline__ void finish(Acc& acc, f32x4 (&accx)[2], const Unit& u, int wr, int wc, int fr, int fq, int wid) const {
        asm volatile("s_waitcnt vmcnt(0)\n\ts_barrier" ::: "memory");
        if (wid == 0 && fr == 0 && fq == 0) {
            unsigned* c = pcnt + 64 * u.pm;
            __hip_atomic_fetch_add(c, 1u, __ATOMIC_RELAXED, __HIP_MEMORY_SCOPE_AGENT);
            unsigned sp = 0u;
            while (__hip_atomic_load(c, __ATOMIC_RELAXED, __HIP_MEMORY_SCOPE_AGENT) < 8u) { __builtin_amdgcn_s_sleep(1);
                if (++sp > (1u << 22)) { __hip_atomic_store(tmo, 0x900u | (unsigned)u.pm, __ATOMIC_RELAXED, __HIP_MEMORY_SCOPE_AGENT); break; } }
        }
        asm volatile("s_waitcnt vmcnt(0) lgkmcnt(0)\n\ts_barrier" ::: "memory");
        const int row0 = u.pm * BM + wr * 64 + fr, cseg = wc * 32 + 8 * fq;
        float sq[2][4];
#pragma unroll
        for (int ai = 0; ai < 2; ++ai)
#pragma unroll
            for (int m = 0; m < 4; ++m) sq[ai][m] = __builtin_bit_cast(float, __hip_atomic_load((const unsigned*)(ssq_out + row0 + ai * HALF + m * 16), __ATOMIC_RELAXED, __HIP_MEMORY_SCOPE_AGENT));
        const int rx = MP + 16 * u.pm + fr;
        const float sqx = __builtin_bit_cast(float, __hip_atomic_load((const unsigned*)(ssq_out + rx), __ATOMIC_RELAXED, __HIP_MEMORY_SCOPE_AGENT));
        f32x4 g4[2][2];
#pragma unroll
        for (int bj = 0; bj < 2; ++bj)
#pragma unroll
            for (int n = 0; n < 2; ++n) g4[bj][n] = ldg<f32x4>(gfin, (unsigned)(u.pn * BM + bj * HALF + cseg + 4 * n) * 4u);
#pragma unroll
        for (int ai = 0; ai < 2; ++ai)
#pragma unroll
            for (int m = 0; m < 4; ++m) { const float rs = __builtin_amdgcn_rsqf(sq[ai][m] * (1.f / D) + EPS); const unsigned oe = (unsigned)((row0 + ai * HALF + m * 16) * D + u.pn * BM + cseg);
#pragma unroll
                for (int bj = 0; bj < 2; ++bj)
#pragma unroll
                    for (int n = 0; n < 2; ++n) stg(out, (oe + bj * HALF + 4 * n) * 4u, acc[ai][bj][m][n] * rs * g4[bj][n]); }
        { const float rs = __builtin_amdgcn_rsqf(sqx * (1.f / D) + EPS); const unsigned oe = (unsigned)(rx * D + u.pn * BM + cseg + 4 * wr);
#pragma unroll
          for (int bj = 0; bj < 2; ++bj) stg(out, (oe + bj * HALF) * 4u, accx[bj] * rs * g4[bj][wr]); }
    }
};

struct EpiRetIn {
    static constexpr bool RSTD = true, SSQ = false; static constexpr int PRE = 0, PB = 1;
    bf16* P; const float* ssq_in; const float* rope;
    template <int NV> __device__ __forceinline__ float seg(int row, int cseg, int pn, const f32x4* v0, const f32x4* v1, float rs, bool smp, const f32x4*) const {
        const int kind = pn < 8 ? 0 : (pn < 16 ? 1 : (pn < 32 ? 2 : 3));
        const unsigned pb = (unsigned)(row * NPROJ + pn * BM + cseg) * 2u;
        f32x4 o1[NV], o2[NV];
        if (kind <= 1) {
            const int pi = smp ? SEQ + ((row - MP) & 3) : (row & (SEQ - 1));
            float sc = rs;
            if (kind == 1) sc *= 0.0625f * (smp ? 1.f : __builtin_amdgcn_exp2f(-(float)((row & 127) + 1) * gamma_l2(pn - 8)));
#pragma unroll
            for (int n = 0; n < NV; ++n) { const f32x4 c = ldg<f32x4>(rope, (unsigned)(pi * 128 + cseg + 4 * n) * 4u), s_ = ldg<f32x4>(rope, (unsigned)((NPOS + pi) * 128 + cseg + 4 * n) * 4u);
                const f32x4 x1 = v0[n] * sc, x2 = v1[n] * sc;
                o1[n] = x1 * c - x2 * s_; o2[n] = x1 * s_ + x2 * c; }
        } else {
#pragma unroll
            for (int n = 0; n < NV; ++n) { o1[n] = v0[n] * rs; o2[n] = v1[n] * rs;
                if (kind == 3) {
#pragma unroll
                    for (int k = 0; k < 4; ++k) { o1[n][k] = silu_f(o1[n][k]); o2[n][k] = silu_f(o2[n][k]); } } }
        }
        stg(P, pb, PackT<NV>::pack(o1)); stg(P, pb + HALF * 2, PackT<NV>::pack(o2)); return 0.f;
    }
};

#ifndef ROT_DPP
#define ROT_DPP 1
#endif
#if ROT_DPP
__device__ __forceinline__ float rot1(float x, int) { return __int_as_float(__builtin_amdgcn_update_dpp(0, __float_as_int(x), 0x121  , 0xf, 0xf, false)); }
#else
__device__ __forceinline__ float rot1(float x, int addr) { return __int_as_float(__builtin_amdgcn_ds_bpermute(addr, __float_as_int(x))); }
#endif
__device__ __forceinline__ f32x4 rot4(f32x4 v, int addr) { f32x4 r; r.x = rot1(v.x, addr); r.y = rot1(v.y, addr); r.z = rot1(v.z, addr); r.w = rot1(v.w, addr); return r; }
__device__ __forceinline__ f32x4 sel4(bool c, f32x4 a, f32x4 b) { return (f32x4){c ? a[0] : b[0], c ? a[1] : b[1], c ? a[2] : b[2], c ? a[3] : b[3]}; }
struct EpiUpAct {
    static constexpr bool FIN = false;
    bf16* ACT; const float* ssq_in; float* convP; float* convS; const float* cw; const float* cb; const float* sconv; float* ubnd; LAS float* xch;
    __device__ __forceinline__ void tile(Acc& acc, const Unit& u, int wr, int wc, int fr, int fq) const {
        const int row0 = u.pm * BM + wr * 64 + fr, cseg = wc * 32 + 8 * fq; const bool smp = u.pm >= MP / BM;
        { float rsv[2][4];
#pragma unroll
          for (int ai = 0; ai < 2; ++ai)
#pragma unroll
            for (int m = 0; m < 4; ++m) rsv[ai][m] = ldg<float>(ssq_in, (unsigned)(row0 + ai * HALF + m * 16) * 4u);
#pragma unroll
          for (int ai = 0; ai < 2; ++ai)
#pragma unroll
            for (int m = 0; m < 4; ++m) { const float rs = __builtin_amdgcn_rsqf(rsv[ai][m] * (1.f / D) + EPS);
#pragma unroll
                for (int bj = 0; bj < 2; ++bj)
#pragma unroll
                    for (int n = 0; n < 2; ++n) acc[ai][bj][m][n] = acc[ai][bj][m][n] * rs; } }
        { float* cbase = smp ? convS : convP;
#pragma unroll
          for (int ai = 0; ai < 2; ++ai)
#pragma unroll
            for (int m = 0; m < 4; ++m) { const int row = row0 + ai * HALF + m * 16; int crow = -1;
                if (!smp) { const int t = row & (SEQ - 1); if (t >= SEQ - 2) crow = (row >> 11) * 2 + (t - (SEQ - 2)); }
                else { const int s_ = row - MP, t = s_ & 3; if (t >= 2) crow = (s_ >> 2) * 2 + (t - 2); }
                if (crow >= 0) {
#pragma unroll
                    for (int bj = 0; bj < 2; ++bj)
#pragma unroll
                        for (int n = 0; n < 2; ++n) stg(cbase, (unsigned)(crow * F2 + bj * FF + u.pn * HALF + cseg + 4 * n) * 4u, acc[ai][bj][m][n]); } } }
        if (fr >= 14) {
#pragma unroll
            for (int ai = 0; ai < 2; ++ai)
#pragma unroll
                for (int bj = 0; bj < 2; ++bj)
#pragma unroll
                    for (int n = 0; n < 2; ++n) *(LAS f32x4*)(xch + ((ai * 2 + wr) * 2 + (fr - 14)) * 256 + bj * HALF + cseg + 4 * n) = acc[ai][bj][3][n]; }
        if (!smp) {
            if (wr == 0 && fr < 2) {
#pragma unroll
                for (int bj = 0; bj < 2; ++bj)
#pragma unroll
                    for (int n = 0; n < 2; ++n) stg(ubnd, (unsigned)((u.pm * 4 + fr) * F2 + u.pn * BM + bj * HALF + cseg + 4 * n) * 4u, acc[0][bj][0][n]); }
            if (wr == 1 && fr >= 14) {
#pragma unroll
                for (int bj = 0; bj < 2; ++bj)
#pragma unroll
                    for (int n = 0; n < 2; ++n) stg(ubnd, (unsigned)((u.pm * 4 + 2 + (fr - 14)) * F2 + u.pn * BM + bj * HALF + cseg + 4 * n) * 4u, acc[1][bj][3][n]); }
        }
        asm volatile("s_waitcnt lgkmcnt(0)\n\ts_barrier" ::: "memory");
        const int lane = fq * 16 + fr, baddr = ((lane & 48) | ((fr - 1) & 15)) * 4;
        const bool f1 = fr >= 1, t1 = (fr & 3) >= 1;
#pragma unroll
        for (int n = 0; n < 2; ++n) {
            const int f4 = u.pn * HALF + cseg + 4 * n;
            f32x4 wg[3], wu[3];
#pragma unroll
            for (int j = 0; j < 3; ++j) { wg[j] = ldg<f32x4>(cw, (unsigned)(j * F2 + f4) * 4u); wu[j] = ldg<f32x4>(cw, (unsigned)(j * F2 + FF + f4) * 4u); }
            const f32x4 bg = ldg<f32x4>(cb, (unsigned)f4 * 4u), bu = ldg<f32x4>(cb, (unsigned)(FF + f4) * 4u);
            f32x4 rgp = (f32x4){0.f, 0.f, 0.f, 0.f}, rup = rgp, r1gp = rgp, r1up = rgp;
#pragma unroll
            for (int ai = 0; ai < 2; ++ai)
#pragma unroll
                for (int m = 0; m < 4; ++m) {
                    const int row = row0 + ai * HALF + m * 16;
                    const f32x4 cg = acc[ai][0][m][n], cu = acc[ai][1][m][n];
                    const f32x4 rg = rot4(cg, baddr), ru = rot4(cu, baddr);
                    f32x4 p1g, p1u, p2g, p2u;
                    if (!smp) {
                        if (m == 0) {
                            f32x4 x0g = (f32x4){0.f, 0.f, 0.f, 0.f}, x1g = x0g, x0u = x0g, x1u = x0g;
                            const int bi = ai * 2 + wr;
                            if (bi > 0) { const LAS float* xp = xch + ((bi - 1) * 2) * 256 + cseg + 4 * n;
                                x0g = *(const LAS f32x4*)xp; x1g = *(const LAS f32x4*)(xp + 256); x0u = *(const LAS f32x4*)(xp + HALF); x1u = *(const LAS f32x4*)(xp + 256 + HALF); }
                            p1g = sel4(f1, rg, x1g); p1u = sel4(f1, ru, x1u);
                            const f32x4 r1g = rot4(p1g, baddr), r1u = rot4(p1u, baddr);
                            p2g = sel4(f1, r1g, x0g); p2u = sel4(f1, r1u, x0u); r1gp = r1g; r1up = r1u;
                        } else {
                            p1g = sel4(f1, rg, rgp); p1u = sel4(f1, ru, rup);
                            const f32x4 r1g = rot4(p1g, baddr), r1u = rot4(p1u, baddr);
                            p2g = sel4(f1, r1g, r1gp); p2u = sel4(f1, r1u, r1up); r1gp = r1g; r1up = r1u;
                        }
                    } else {
                        const unsigned so = (unsigned)(((row - MP) >> 2) * 2 * F2 + f4) * 4u;
                        const f32x4 s0g = ldg<f32x4>(sconv, so), s1g = ldg<f32x4>(sconv, so + F2 * 4u), s0u = ldg<f32x4>(sconv, so + FF * 4u), s1u = ldg<f32x4>(sconv, so + (F2 + FF) * 4u);
                        p1g = sel4(t1, rg, s1g); p1u = sel4(t1, ru, s1u);
                        const f32x4 r1g = rot4(p1g, baddr), r1u = rot4(p1u, baddr);
                        p2g = sel4(t1, r1g, s0g); p2u = sel4(t1, r1u, s0u);
                    }
                    rgp = rg; rup = ru;
                    const f32x4 gg = wg[0] * p2g + wg[1] * p1g + wg[2] * cg + bg, uu = wu[0] * p2u + wu[1] * p1u + wu[2] * cu + bu;
                    u32x2 w; w.x = pk2(silu_f(gg[0]) * uu[0], silu_f(gg[1]) * uu[1]); w.y = pk2(silu_f(gg[2]) * uu[2], silu_f(gg[3]) * uu[3]);
                    stg(ACT, (unsigned)(row * FF + f4) * 2u, w);
                }
        }
    }
    template <bool XT> __device__ __forceinline__ void run(Acc& acc, f32x4 (&)[2], const Unit& u, int wr, int wc, int fr, int fq) const { tile(acc, u, wr, wc, fr, fq); }
};
}

#define XB_TMO      128
#define XB_XCNT(j)  (256  + 64 * (j))
#define XB_XSUB(j)  (1280 + 64 * (j))
#define XB_XGEN(j)  (2304 + 64 * (j))
#define XB_TOP      3328
#define XB_TOPGEN   3392
#define XCD_BAR_WORDS 3456
#define XB_SPIN_CAP (1u << 22)
__device__ __forceinline__ unsigned xb_ld(unsigned* p)              { return __hip_atomic_load(p, __ATOMIC_RELAXED, __HIP_MEMORY_SCOPE_AGENT); }
__device__ __forceinline__ unsigned xb_add(unsigned* p, unsigned v) { return __hip_atomic_fetch_add(p, v, __ATOMIC_RELAXED, __HIP_MEMORY_SCOPE_AGENT); }
__device__ __forceinline__ unsigned xb_xcc_id() { return (unsigned)__builtin_amdgcn_s_getreg((3 << 11) | 20) & 0xFu; }
#define XB_SPIN(cond, bar) do { unsigned _sp = 0; while (cond) { __builtin_amdgcn_s_sleep(1); \
    if ((++_sp & 255u) == 0u) { if (xb_ld(&(bar)[XB_TMO])) break; if (_sp > XB_SPIN_CAP) { atomicAdd(&(bar)[XB_TMO], 1u); break; } } } } while (0)
struct XcdBarrier { unsigned* bar; unsigned x; volatile LAS unsigned* st; };
__device__ __forceinline__ XcdBarrier xcd_barrier_post(unsigned* bar, volatile LAS unsigned* st) {
    XcdBarrier b; b.bar = bar; b.x = xb_xcc_id(); b.st = st;
    if (threadIdx.x == 0) (void)xb_add(&bar[XB_XCNT(b.x)], 1u);
    return b;
}
__device__ __forceinline__ void xcd_barrier_complete(unsigned* bar, unsigned x, unsigned& nloc, unsigned& nx) {
    const unsigned G = gridDim.x * gridDim.y * gridDim.z;
    unsigned sum, cnt, mine, sp = 0u;
    for (;;) {
        sum = 0u; cnt = 0u; mine = 0u;
#pragma unroll
        for (unsigned j = 0; j < 16; ++j) { const unsigned c = xb_ld(&bar[XB_XCNT(j)]); sum += c; cnt += (c > 0u) ? 1u : 0u; mine = (j == x) ? c : mine; }
        if (sum == G) break;
        __builtin_amdgcn_s_sleep(1);
        if ((++sp & 255u) == 0u) { if (xb_ld(&bar[XB_TMO])) break; if (sp > XB_SPIN_CAP) { atomicAdd(&bar[XB_TMO], 1u); break; } }
    }
    nloc = mine > 0u ? mine : 1u; nx = cnt > 0u ? cnt : 1u;
}
__device__ __forceinline__ void xcd_barrier(const XcdBarrier& b, int wave_s) {
    asm volatile("s_waitcnt vmcnt(0)" ::: "memory");
    __syncthreads();
    if (wave_s == 0 && __builtin_amdgcn_mbcnt_hi(~0u, __builtin_amdgcn_mbcnt_lo(~0u, 0u)) == 0u) {
        unsigned* bar = b.bar;
        __builtin_amdgcn_s_waitcnt(0);
        unsigned nloc = b.st[0], nx = b.st[1];
        if (nloc == 0u) { xcd_barrier_complete(bar, b.x, nloc, nx); b.st[0] = nloc; b.st[1] = nx; }
        const unsigned old = xb_add(&bar[XB_XSUB(b.x)], 1u);
        const unsigned gen = old / nloc;
        if (old + 1u == (gen + 1u) * nloc) {
            __builtin_amdgcn_fence(__ATOMIC_RELEASE, "agent");
            asm volatile("s_waitcnt vmcnt(0)" ::: "memory");
            const unsigned og = xb_add(&bar[XB_TOP], 1u);
            const unsigned tg = og / nx;
            if (og + 1u == (tg + 1u) * nx) xb_add(&bar[XB_TOPGEN], 1u);
            else XB_SPIN(xb_ld(&bar[XB_TOPGEN]) == tg, bar);
            __builtin_amdgcn_fence(__ATOMIC_ACQUIRE, "agent");
            xb_add(&bar[XB_XGEN(b.x)], 1u);
            asm volatile("s_waitcnt vmcnt(0)" ::: "memory");
        } else {
            XB_SPIN(xb_ld(&bar[XB_XGEN(b.x)]) == gen, bar);
            __builtin_amdgcn_fence(__ATOMIC_ACQUIRE, "agent");
            asm volatile("s_waitcnt vmcnt(0)" ::: "memory");
        }
    }
    __syncthreads();
}

struct Args { const float* in[21]; float* out; unsigned char* ws; int ph_lo, ph_hi; };
static_assert(sizeof(Args) == 21 * 8 + 8 + 8 + 8, "Args has no padding");

struct TItem { const float* W; bf16* WT; const float* gain; int K, N, row_off, mode, item; };
__device__ __forceinline__ void p0_tr_load(const TItem& t, f32x4 (&v)[8], float (&gv)[8], int lane) {
    const int nblk = t.N / 32, kb = t.item / nblk, nb = t.item % nblk, k0 = 64 * kb, n0 = 32 * nb, kr = lane >> 3, nq = lane & 7;
#pragma unroll
    for (int i = 0; i < 8; ++i) v[i] = __builtin_nontemporal_load((const f32x4*)(t.W + (size_t)(k0 + 8 * i + kr) * t.N + n0 + 4 * nq));
#pragma unroll
    for (int i = 0; i < 8; ++i) gv[i] = t.gain ? t.gain[k0 + 8 * i + kr] : 1.f;
}
__device__ __forceinline__ void p0_tr_store(const TItem& t, const f32x4 (&v)[8], const float (&gv)[8], LAS float* scr, int lane) {
    const int nblk = t.N / 32, kb = t.item / nblk, nb = t.item % nblk, k0 = 64 * kb, n0 = 32 * nb, kr = lane >> 3, nq = lane & 7;
#pragma unroll
    for (int i = 0; i < 8; ++i) { const int kk = 8 * i + kr; const f32x4 w = v[i] * gv[i];
        LAS float* d = scr + kk * 33 + 4 * nq; d[0] = w[0]; d[1] = w[1]; d[2] = w[2]; d[3] = w[3]; }
    asm volatile("s_waitcnt lgkmcnt(0)" ::: "memory");
    int drow0 = t.row_off + n0;
    if (t.mode == 1) drow0 = (n0 < FF) ? 256 * (n0 >> 7) + (n0 & 127) : 256 * ((n0 - FF) >> 7) + 128 + ((n0 - FF) & 127);
    const int c = lane & 7;
#pragma unroll
    for (int j = 0; j < 4; ++j) { const int n = (lane >> 3) + 8 * j; const LAS float* s_ = scr + (8 * c) * 33 + n;
        u32x4 o; o.x = pk2(s_[0 * 33], s_[1 * 33]); o.y = pk2(s_[2 * 33], s_[3 * 33]); o.z = pk2(s_[4 * 33], s_[5 * 33]); o.w = pk2(s_[6 * 33], s_[7 * 33]);
        *(u32x4*)(t.WT + (size_t)(drow0 + n) * t.K + k0 + 8 * c) = o; }
    asm volatile("s_waitcnt lgkmcnt(0)" ::: "memory");
}

__device__ __forceinline__ void sincos_d(double a, double& s, double& c) {
    const double kq = __builtin_rint(a * 0.63661977236758134308);
    double r = __builtin_fma(-kq, 1.57079632679489655800e+00, a); r = __builtin_fma(-kq, 6.12323399573676603587e-17, r);
    const int q = (int)((long long)kq & 3);
    const double r2 = r * r;
    const double sp = r * (1.0 + r2 * (-1.0 / 6 + r2 * (1.0 / 120 + r2 * (-1.0 / 5040 + r2 * (1.0 / 362880 + r2 * (-1.0 / 39916800 + r2 * (1.0 / 6227020800.0)))))));
    const double cp = 1.0 + r2 * (-0.5 + r2 * (1.0 / 24 + r2 * (-1.0 / 720 + r2 * (1.0 / 40320 + r2 * (-1.0 / 3628800 + r2 * (1.0 / 479001600 + r2 * (-1.0 / 87178291200.0)))))));
    s = (q == 0) ? sp : (q == 1) ? cp : (q == 2) ? -sp : -cp;
    c = (q == 0) ? cp : (q == 1) ? -sp : (q == 2) ? -cp : sp;
}

__device__ __forceinline__ void p0_pool_item(const Args& a, LAS unsigned char* lds, int item, int tid, int wave, int lane) {
    LAS float* rs = (LAS float*)lds;
    const bool prompt = item < 256;
    const float* xbase; int nrows, nhalo, b, t0;
    if (prompt) { b = item >> 6; t0 = (item & 63) * 32; xbase = a.in[0] + (size_t)b * SEQ * D; nrows = 47; nhalo = 15; }
    else { b = item - 256; t0 = 0; xbase = a.in[1] + (size_t)b * DS * D; nrows = 19; nhalo = 15; }
    for (int e0 = wave; e0 < nrows; e0 += 2 * NWAVES) {
        f32x4 xv[2][8]; float r[2] = {0.f, 0.f};
#pragma unroll
        for (int h = 0; h < 2; ++h) { const int e = e0 + h * NWAVES, t = t0 - nhalo + e;
            if (e < nrows && t >= 0) { const f32x4* xr = (const f32x4*)(xbase + (size_t)t * D) + lane;
#pragma unroll
                for (int j = 0; j < 8; ++j) xv[h][j] = xr[64 * j]; } }
#pragma unroll
        for (int h = 0; h < 2; ++h) { const int e = e0 + h * NWAVES, t = t0 - nhalo + e;
            if (e < nrows) {
                if (t >= 0) { float s_ = 0.f;
#pragma unroll
                    for (int j = 0; j < 8; ++j) { const f32x4 v = xv[h][j]; s_ += (v.x * v.x + v.y * v.y) + (v.z * v.z + v.w * v.w); }
                    r[h] = __builtin_amdgcn_rsqf(wave_sum(s_) * (1.f / D) + EPS); }
                if (lane == 0) rs[e] = r[h]; } }
    }
    __syncthreads();
    const int c0 = 4 * tid, win = 2 << (tid >> 7);
    const f32x4 g4 = *(const f32x4*)(a.in[7] + c0);
    bf16* DPRE = (bf16*)(a.ws + WS_DPRE);
    f32x4 w[16];
#pragma unroll
    for (int j = 0; j < 16; ++j) w[j] = (f32x4){0.f, 0.f, 0.f, 0.f};
    for (int e0 = 0; e0 < nrows; e0 += 8) {
        f32x4 xv[8];
#pragma unroll
        for (int i = 0; i < 8; ++i) { const int e = e0 + i, t = t0 - nhalo + e;
            xv[i] = (f32x4){0.f, 0.f, 0.f, 0.f};
            if (e < nrows) {
                if (prompt) { if (t >= 0) xv[i] = *(const f32x4*)(xbase + (size_t)t * D + c0); }
                else { if (e < 15) xv[i] = *(const f32x4*)(a.in[4] + ((size_t)b * PBUF + e) * D + c0); else xv[i] = *(const f32x4*)(xbase + (size_t)t * D + c0); } } }
#pragma unroll
        for (int i = 0; i < 8; ++i) { const int e = e0 + i, t = t0 - nhalo + e;
            if (e < nrows) {
                f32x4 hv = xv[i];
                if (prompt || e >= 15) hv = hv * rs[e] * g4;
#pragma unroll
                for (int j = 15; j > 0; --j) w[j] = w[j - 1];
                w[0] = hv;
                if (e >= nhalo) {
                    f32x4 s4 = (f32x4){0.f, 0.f, 0.f, 0.f};
#pragma unroll
                    for (int j = 0; j < 16; ++j) if (j < win) s4 += w[j];
                    const int cnt = prompt ? ((t + 1 < win) ? t + 1 : win) : win;
                    const f32x4 d = s4 * (1.f / (float)cnt) - hv;
                    const int row = prompt ? b * SEQ + t : MP + b * DS + t;
                    u32x2 o; o.x = pk2(d[0], d[1]); o.y = pk2(d[2], d[3]);
                    *(u32x2*)(DPRE + (size_t)row * D + c0) = o;
                }
                if (prompt) { if (t >= SEQ - PBUF) *(f32x4*)(a.out + O_PP + ((size_t)b * PBUF + (t - (SEQ - PBUF))) * D + c0) = hv; }
                else { if (e >= 4) *(f32x4*)(a.out + O_PS + ((size_t)b * PBUF + (e - 4)) * D + c0) = hv; }
            } }
    }
    __syncthreads();
}

#define LAUNDER_TID() int wave = __builtin_amdgcn_readfirstlane(wave_s); int lane = (int)__builtin_amdgcn_mbcnt_hi(~0u, __builtin_amdgcn_mbcnt_lo(~0u, 0u)); asm volatile("" : "+v"(lane)); int tid = wave * 64 + lane; (void)tid
__device__ __forceinline__ void p0_prologue(const Args& a, LAS unsigned char* lds, int wave_s) {
    LAUNDER_TID();
    const int G = gridDim.x, gw = blockIdx.x * NWAVES + wave, NGW = G * NWAVES;
    unsigned char* ws = a.ws;
    LAS float* scr = (LAS float*)(lds + wave * 16384);
    constexpr int I_POOL = 8 * 16, I_WP = 4 * 64, I_WG = 32 * 64, I_UP = 32 * 352, I_DN = 88 * 64, I_IN = 32 * 384, I_OUT = 64 * 64;
    constexpr int NITEMS = 4 * I_POOL + 2 * I_WP + 2 * I_WG + 2 * I_UP + 2 * I_DN + I_IN + I_OUT;
    auto decode = [&](int it) -> TItem {
        int r = it;
        if (r < 4 * I_POOL) { const int gI = r / I_POOL; return TItem{a.in[11] + (size_t)gI * 512 * 512, (bf16*)(ws + WS_WPOOL), nullptr, 512, 512, gI * 512, 0, r % I_POOL}; } r -= 4 * I_POOL;
        if (r < 2 * I_WP) { const int l = r / I_WP; return TItem{a.in[19] + (size_t)l * PLE * D, (bf16*)(ws + WS_WP) + (size_t)l * D * PLE, nullptr, PLE, D, 0, 0, r % I_WP}; } r -= 2 * I_WP;
        if (r < 2 * I_WG) { const int l = r / I_WG; return TItem{a.in[20] + (size_t)l * D * D, (bf16*)(ws + WS_WG) + (size_t)l * D * D, a.in[9] + l * D, D, D, 0, 0, r % I_WG}; } r -= 2 * I_WG;
        if (r < 2 * I_UP) { const int l = r / I_UP; return TItem{a.in[15] + (size_t)l * D * F2, (bf16*)(ws + WS_WUP) + (size_t)l * F2 * D, a.in[8] + l * D, D, F2, 0, 1, r % I_UP}; } r -= 2 * I_UP;
        if (r < 2 * I_DN) { const int l = r / I_DN; return TItem{a.in[18] + (size_t)l * FF * D, (bf16*)(ws + WS_WDN) + (size_t)l * D * FF, nullptr, FF, D, 0, 0, r % I_DN}; } r -= 2 * I_DN;
        if (r < I_IN) return TItem{a.in[13], (bf16*)(ws + WS_WIN), a.in[7] + D, D, NPROJ, 0, 0, r}; r -= I_IN;
        return TItem{a.in[14], (bf16*)(ws + WS_WOUT), nullptr, 4096, D, 0, 0, r};
    };
    if (gw < NITEMS) {
        TItem cur = decode(gw); f32x4 v[8]; float gv[8];
        p0_tr_load(cur, v, gv, lane);
        for (int it = gw; it < NITEMS; it += NGW) {
            const bool has = it + NGW < NITEMS;
            TItem nxt = cur; f32x4 vn[8]; float gn[8];
            if (has) { nxt = decode(it + NGW); p0_tr_load(nxt, vn, gn, lane); }
            p0_tr_store(cur, v, gv, scr, lane);
            if (has) { cur = nxt;
#pragma unroll
                for (int i = 0; i < 8; ++i) { v[i] = vn[i]; gv[i] = gn[i]; } }
        }
    }
    const int gt = blockIdx.x * NT + tid, NGT = G * NT;
    for (int i = gt; i < 2 * M * PLE / 8; i += NGT) {
        const int e = i * 8, l = e / (M * PLE), rem = e - l * (M * PLE), m = rem / PLE, c = rem % PLE;
        const float* src = (m < MP) ? a.in[2] + ((size_t)l * MP + m) * PLE + c : a.in[3] + ((size_t)l * MS + (m - MP)) * PLE + c;
        const f32x4 v0 = *(const f32x4*)src, v1 = *(const f32x4*)(src + 4);
        { u32x4 w; w.x = pk2(v0[0], v0[1]); w.y = pk2(v0[2], v0[3]); w.z = pk2(v1[0], v1[1]); w.w = pk2(v1[2], v1[3]); *(u32x4*)((bf16*)(ws + WS_PB) + e) = w; }
    }
    float* rope = (float*)(ws + WS_ROPE);
    for (int i = gt; i < NPOS * 128; i += NGT) {
        const int pi = i >> 7, j = i & 127;
        const double pos = (pi < SEQ) ? (double)pi : (double)(PAST + (pi - SEQ));
        const double inv = exp(-(double)j * (9.210340371976182736 / 128.0));
        double s, c; sincos_d(pos * inv, s, c);
        rope[i] = (float)c; rope[NPOS * 128 + i] = (float)s;
    }
    __syncthreads();
    for (int it = blockIdx.x; it < 256 + DB; it += G) p0_pool_item(a, lds, it, tid, wave, lane);
}

__device__ __forceinline__ void act_phase(const Args& a, int layer, int wave_s) {
    LAUNDER_TID();
    const int G = gridDim.x, gw = blockIdx.x * NWAVES + wave, NGW = G * NWAVES;
    const bf16* U = (const bf16*)(a.ws + WS_U); bf16* ACT = (bf16*)(a.ws + WS_ACT);
    const float* cw = a.in[16] + (size_t)layer * 3 * F2; const float* cb = a.in[17] + (size_t)layer * F2;
    const float* sconv = a.in[6] + (size_t)layer * DB * 2 * F2;
    constexpr int NRR = M / 32, NCB = FF / 512;
    for (int it = gw; it < NRR * NCB; it += NGW) {
        const int rr = it / NCB, cbk = it % NCB, m0 = rr * 32, f0 = cbk * 512 + lane * 8;
        const int ug = 256 * (f0 >> 7) + (f0 & 127), uu = ug + 128;
        float wg[3][8], wu[3][8], bg[8], bu[8];
#pragma unroll
        for (int j = 0; j < 3; ++j)
#pragma unroll
            for (int h = 0; h < 2; ++h) { const f32x4 vg = *(const f32x4*)(cw + (size_t)j * F2 + f0 + 4 * h), vu = *(const f32x4*)(cw + (size_t)j * F2 + FF + f0 + 4 * h);
#pragma unroll
                for (int e = 0; e < 4; ++e) { wg[j][4 * h + e] = vg[e]; wu[j][4 * h + e] = vu[e]; } }
#pragma unroll
        for (int h = 0; h < 2; ++h) { const f32x4 vg = *(const f32x4*)(cb + f0 + 4 * h), vu = *(const f32x4*)(cb + FF + f0 + 4 * h);
#pragma unroll
            for (int e = 0; e < 4; ++e) { bg[4 * h + e] = vg[e]; bu[4 * h + e] = vu[e]; } }
        float p1g[8], p2g[8], p1u[8], p2u[8];
        for (int r = 0; r < 32; ++r) {
            const int m = m0 + r; const bool prompt = m < MP; const int t = prompt ? (m & (SEQ - 1)) : ((m - MP) & 3);
            if (r == 0 || t == 0) {
#pragma unroll
                for (int back = 2; back >= 1; --back) {
                    float tg[8], tu[8]; const int tt = t - back;
                    if (tt >= 0) { const u32x4 vg = *(const u32x4*)(U + (size_t)(m - back) * F2 + ug), vu = *(const u32x4*)(U + (size_t)(m - back) * F2 + uu);
                        tg[0] = bflo(vg.x); tg[1] = bfhi(vg.x); tg[2] = bflo(vg.y); tg[3] = bfhi(vg.y); tg[4] = bflo(vg.z); tg[5] = bfhi(vg.z); tg[6] = bflo(vg.w); tg[7] = bfhi(vg.w);
                        tu[0] = bflo(vu.x); tu[1] = bfhi(vu.x); tu[2] = bflo(vu.y); tu[3] = bfhi(vu.y); tu[4] = bflo(vu.z); tu[5] = bfhi(vu.z); tu[6] = bflo(vu.w); tu[7] = bfhi(vu.w); }
                    else if (prompt) {
#pragma unroll
                        for (int e = 0; e < 8; ++e) { tg[e] = 0.f; tu[e] = 0.f; } }
                    else { const float* sp = sconv + ((size_t)((m - MP) >> 2) * 2 + (2 + tt)) * F2;
#pragma unroll
                        for (int h = 0; h < 2; ++h) { const f32x4 vg = *(const f32x4*)(sp + f0 + 4 * h), vu = *(const f32x4*)(sp + FF + f0 + 4 * h);
#pragma unroll
                            for (int e = 0; e < 4; ++e) { tg[4 * h + e] = vg[e]; tu[4 * h + e] = vu[e]; } } }
#pragma unroll
                    for (int e = 0; e < 8; ++e) { if (back == 2) { p2g[e] = tg[e]; p2u[e] = tu[e]; } else { p1g[e] = tg[e]; p1u[e] = tu[e]; } }
                }
            }
            const u32x4 vg = *(const u32x4*)(U + (size_t)m * F2 + ug), vu = *(const u32x4*)(U + (size_t)m * F2 + uu);
            float cg[8], cu[8];
            cg[0] = bflo(vg.x); cg[1] = bfhi(vg.x); cg[2] = bflo(vg.y); cg[3] = bfhi(vg.y); cg[4] = bflo(vg.z); cg[5] = bfhi(vg.z); cg[6] = bflo(vg.w); cg[7] = bfhi(vg.w);
            cu[0] = bflo(vu.x); cu[1] = bfhi(vu.x); cu[2] = bflo(vu.y); cu[3] = bfhi(vu.y); cu[4] = bflo(vu.z); cu[5] = bfhi(vu.z); cu[6] = bflo(vu.w); cu[7] = bfhi(vu.w);
            float o[8];
#pragma unroll
            for (int e = 0; e < 8; ++e) { const float gg = wg[0][e] * p2g[e] + wg[1][e] * p1g[e] + wg[2][e] * cg[e] + bg[e], up = wu[0][e] * p2u[e] + wu[1][e] * p1u[e] + wu[2][e] * cu[e] + bu[e];
                o[e] = silu_f(gg) * up; p2g[e] = p1g[e]; p1g[e] = cg[e]; p2u[e] = p1u[e]; p1u[e] = cu[e]; }
            u32x4 w; w.x = pk2(o[0], o[1]); w.y = pk2(o[2], o[3]); w.z = pk2(o[4], o[5]); w.w = pk2(o[6], o[7]);
            *(u32x4*)(ACT + (size_t)m * FF + f0) = w;
        }
    }
}

__device__ __forceinline__ bf16x8 cat8(s16x4 a, s16x4 b) { return __builtin_shufflevector(a, b, 0, 1, 2, 3, 4, 5, 6, 7); }
typedef short v4i16_t __attribute__((ext_vector_type(4)));
__device__ __forceinline__ s16x4 vtr(const LAS unsigned char* p) { return __builtin_bit_cast(s16x4, __builtin_amdgcn_ds_read_tr16_b64_v4i16((LAS v4i16_t*)p)); }
#define LBAR() asm volatile("s_waitcnt lgkmcnt(0)\n\ts_barrier" ::: "memory")
constexpr int KN_P = 528, VN_P = 144, ST_P = 528;
constexpr int KN_OFF = 0, VN_OFF = 128 * KN_P, ST_OFF = VN_OFF + 128 * VN_P, RET_LDS_END = ST_OFF + 64 * ST_P;
static_assert(RET_LDS_END <= RING_BYTES, "retention LDS");
static_assert(XCH_OFF + XCH_BYTES <= LDS_BYTES, "LDS map");

__device__ __forceinline__ void ret_prompt_item(const Args& a, LAS unsigned char* lds, int item, int wave_s) {
    LAUNDER_TID();
    const int b = item >> 6, h = (item >> 3) & 7, sl = item & 7, fr = lane & 15, fq = lane >> 4;
    const bf16* PROJ = (const bf16*)(a.ws + WS_PROJ); bf16* OB = (bf16*)(a.ws + WS_OB);
    LAS unsigned char* Kn = lds + KN_OFF; LAS unsigned char* Vn = lds + VN_OFF; LAS unsigned char* St = lds + ST_OFF;
    const float l2g = gamma_l2(h);
    const int qb = (wave < 4) ? wave : 11 - wave;
    const float sdec = __builtin_amdgcn_exp2f(128.f * l2g), cross = __builtin_amdgcn_exp2f((float)(16 * qb + fr + 1) * l2g);
    for (int i = tid; i < 64 * ST_P / 16; i += NT) ((LAS u32x4*)St)[i] = (u32x4){0u, 0u, 0u, 0u};
    f32x4 S[2][4];
#pragma unroll
    for (int x = 0; x < 2; ++x)
#pragma unroll
        for (int y = 0; y < 4; ++y) S[x][y] = (f32x4){0.f, 0.f, 0.f, 0.f};
    u32x4 kst[8], vst[2]; bf16x8 qf[8];
    const char* kbase = (const char*)(PROJ + (size_t)b * SEQ * NPROJ + 2048 + h * DK);
    const char* vbase = (const char*)(PROJ + (size_t)b * SEQ * NPROJ + 4096 + h * DV + sl * 64);
    const char* qbase = (const char*)(PROJ + (size_t)b * SEQ * NPROJ + h * DK);
    char* obase = (char*)(OB + (size_t)b * SEQ * 4096 + h * DV + sl * 64);
    const unsigned klane = (unsigned)((tid >> 5) * NPROJ + (tid & 31) * 8) * 2u, vlane = (unsigned)((tid >> 3) * NPROJ + (tid & 7) * 8) * 2u;
    const unsigned qlane = (unsigned)((16 * qb + fr) * NPROJ + 8 * fq) * 2u, olane = (unsigned)((16 * qb + fr) * 4096 + 4 * fq) * 2u;
    constexpr size_t CH_IN = (size_t)128 * NPROJ * 2, CH_OUT = (size_t)128 * 4096 * 2;
#define RET_LOAD_KV(c) do { const char* kc = kbase + (size_t)(c) * CH_IN; const char* vc = vbase + (size_t)(c) * CH_IN; \
        _Pragma("unroll") for (int i = 0; i < 8; ++i) kst[i] = *(const u32x4*)(kc + (size_t)i * 16 * NPROJ * 2 + klane); \
        _Pragma("unroll") for (int i = 0; i < 2; ++i) vst[i] = *(const u32x4*)(vc + (size_t)i * 64 * NPROJ * 2 + vlane); } while (0)
#define RET_LOAD_Q(c) do { const char* qc = qbase + (size_t)(c) * CH_IN; \
        _Pragma("unroll") for (int kk = 0; kk < 8; ++kk) qf[kk] = *(const bf16x8*)(qc + 64 * kk + qlane); } while (0)
    RET_LOAD_KV(0); RET_LOAD_Q(0);
    LBAR();
    for (int c = 0; c < 16; ++c) {
#pragma unroll
        for (int i = 0; i < 8; ++i) { const int p = tid + NT * i; *(LAS u32x4*)(Kn + (p >> 5) * KN_P + (p & 31) * 16) = kst[i]; }
#pragma unroll
        for (int i = 0; i < 2; ++i) { const int p = tid + NT * i; *(LAS u32x4*)(Vn + (p >> 3) * VN_P + (p & 7) * 16) = vst[i]; }
        LBAR();
        u32x2 pk[8];
#pragma unroll
        for (int jj = 0; jj < 4; ++jj) {
            pk[2 * jj] = (u32x2){0u, 0u}; pk[2 * jj + 1] = (u32x2){0u, 0u};
            if (2 * jj <= qb) {
                f32x4 p0 = (f32x4){0.f, 0.f, 0.f, 0.f}, p1 = (f32x4){0.f, 0.f, 0.f, 0.f};
#pragma unroll
                for (int kk = 0; kk < 8; ++kk) {
                    const bf16x8 X0 = *(const LAS bf16x8*)(Kn + (32 * jj + fr) * KN_P + (32 * kk + 8 * fq) * 2);
                    const bf16x8 X1 = *(const LAS bf16x8*)(Kn + (32 * jj + 16 + fr) * KN_P + (32 * kk + 8 * fq) * 2);
                    p0 = __builtin_amdgcn_mfma_f32_16x16x32_bf16(X0, qf[kk], p0, 0, 0, 0);
                    p1 = __builtin_amdgcn_mfma_f32_16x16x32_bf16(X1, qf[kk], p1, 0, 0, 0); }
                if (2 * jj == qb) {
#pragma unroll
                    for (int i = 0; i < 4; ++i) { if (4 * fq + i > fr) p0[i] = 0.f; p1[i] = 0.f; } }
                else if (2 * jj + 1 == qb) {
#pragma unroll
                    for (int i = 0; i < 4; ++i) if (4 * fq + i > fr) p1[i] = 0.f; }
                pk[2 * jj].x = pk2(p0[0], p0[1]); pk[2 * jj].y = pk2(p0[2], p0[3]); pk[2 * jj + 1].x = pk2(p1[0], p1[1]); pk[2 * jj + 1].y = pk2(p1[2], p1[3]);
            }
        }
        if (c + 1 < 16) RET_LOAD_KV(c + 1);
        f32x4 o[4];
#pragma unroll
        for (int vb = 0; vb < 4; ++vb) { o[vb] = (f32x4){0.f, 0.f, 0.f, 0.f};
#pragma unroll
            for (int kk = 0; kk < 8; ++kk) { const bf16x8 X = *(const LAS bf16x8*)(St + (16 * vb + fr) * ST_P + (32 * kk + 8 * fq) * 2); o[vb] = __builtin_amdgcn_mfma_f32_16x16x32_bf16(X, qf[kk], o[vb], 0, 0, 0); } }
        if (c + 1 < 16) RET_LOAD_Q(c + 1);
#pragma unroll
        for (int jj = 0; jj < 4; ++jj) {
            if (2 * jj <= qb) {
                const u32x4 yw = (u32x4){pk[2 * jj].x, pk[2 * jj].y, pk[2 * jj + 1].x, pk[2 * jj + 1].y};
                const bf16x8 Y = __builtin_bit_cast(bf16x8, yw);
#pragma unroll
                for (int vb = 0; vb < 4; ++vb) {
                    const s16x4 t0 = vtr(Vn + (32 * jj + 4 * fq + (fr >> 2)) * VN_P + (16 * vb + 4 * (fr & 3)) * 2);
                    const s16x4 t1 = vtr(Vn + (32 * jj + 16 + 4 * fq + (fr >> 2)) * VN_P + (16 * vb + 4 * (fr & 3)) * 2);
                    o[vb] = __builtin_amdgcn_mfma_f32_16x16x32_bf16(cat8(t0, t1), Y, o[vb], 0, 0, 0);
                }
            }
        }
        { char* oc = obase + (size_t)c * CH_OUT;
#pragma unroll
            for (int vb = 0; vb < 4; ++vb) { u32x2 w; w.x = pk2(o[vb][0] * cross, o[vb][1] * cross); w.y = pk2(o[vb][2] * cross, o[vb][3] * cross); *(u32x2*)(oc + 32 * vb + olane) = w; } }
        LBAR();
#pragma unroll
        for (int kk = 0; kk < 4; ++kk) {
            bf16x8 Yv[4];
#pragma unroll
            for (int vb = 0; vb < 4; ++vb) {
                const s16x4 t0 = vtr(Vn + (32 * kk + 8 * fq + (fr >> 2)) * VN_P + (16 * vb + 4 * (fr & 3)) * 2);
                const s16x4 t1 = vtr(Vn + (32 * kk + 8 * fq + 4 + (fr >> 2)) * VN_P + (16 * vb + 4 * (fr & 3)) * 2);
                Yv[vb] = cat8(t0, t1); }
#pragma unroll
            for (int kbl = 0; kbl < 2; ++kbl) { const int kb = 2 * wave + kbl;
                const s16x4 t0 = vtr(Kn + (32 * kk + 8 * fq + (fr >> 2)) * KN_P + (16 * kb + 4 * (fr & 3)) * 2);
                const s16x4 t1 = vtr(Kn + (32 * kk + 8 * fq + 4 + (fr >> 2)) * KN_P + (16 * kb + 4 * (fr & 3)) * 2);
                const bf16x8 X = cat8(t0, t1);
#pragma unroll
                for (int vb = 0; vb < 4; ++vb) S[kbl][vb] = __builtin_amdgcn_mfma_f32_16x16x32_bf16(X, Yv[vb], S[kbl][vb], 0, 0, 0); }
        }
#pragma unroll
        for (int kbl = 0; kbl < 2; ++kbl)
#pragma unroll
            for (int vb = 0; vb < 4; ++vb) { S[kbl][vb] = S[kbl][vb] * sdec; u32x2 w; w.x = pk2(S[kbl][vb][0], S[kbl][vb][1]); w.y = pk2(S[kbl][vb][2], S[kbl][vb][3]);
                *(LAS u32x2*)(St + (16 * vb + fr) * ST_P + (16 * (2 * wave + kbl) + 4 * fq) * 2) = w; }
        LBAR();
    }
#undef RET_LOAD_KV
#undef RET_LOAD_Q
    float* so = a.out + O_RP + ((size_t)(b * RH + h) * DK) * DV + sl * 64;
#pragma unroll
    for (int kbl = 0; kbl < 2; ++kbl)
#pragma unroll
        for (int vb = 0; vb < 4; ++vb)
#pragma unroll
            for (int i = 0; i < 4; ++i) so[(size_t)(16 * (2 * wave + kbl) + 4 * fq + i) * DV + 16 * vb + fr] = S[kbl][vb][i];
}

__device__ __forceinline__ void ret_sample_item(const Args& a, LAS unsigned char* lds, int item, int wave_s) {
    LAUNDER_TID();
    const int b = item >> 3, h = item & 7;
    const bf16* PROJ = (const bf16*)(a.ws + WS_PROJ); bf16* OB = (bf16*)(a.ws + WS_OB);
    LAS float* qs = (LAS float*)lds;
    LAS float* ks = qs + 1024;
    LAS float* scs = ks + 1024;
    LAS float* stat = scs + 16;
    LAS float* red = stat + 16 + 16;
    const float l2g = gamma_l2(h);
    const size_t r0 = (size_t)MP + (size_t)b * DS;
    {
        const int n = tid >> 7, c = (tid & 127) * 2;
        const unsigned wq = *(const unsigned*)(PROJ + (r0 + n) * NPROJ + h * DK + c), wk = *(const unsigned*)(PROJ + (r0 + n) * NPROJ + 2048 + h * DK + c);
        qs[n * 256 + c] = bflo(wq); qs[n * 256 + c + 1] = bfhi(wq); ks[n * 256 + c] = bflo(wk); ks[n * 256 + c + 1] = bfhi(wk);
    }
    __syncthreads();
#pragma unroll
    for (int pp = 0; pp < 2; ++pp) { const int pr = 2 * wave + pp, n = pr >> 2, m = pr & 3; float s = 0.f;
#pragma unroll
        for (int j = 0; j < 4; ++j) s += qs[n * 256 + lane + 64 * j] * ks[m * 256 + lane + 64 * j];
        s = wave_sum(s);
        if (lane == 0) scs[pr] = (m <= n) ? s * __builtin_amdgcn_exp2f((float)(n - m) * l2g) : 0.f; }
    __syncthreads();
    { const int m = tid >> 7, c = (tid & 127) * 2; const float kd = __builtin_amdgcn_exp2f((float)(3 - m) * l2g); ks[m * 256 + c] *= kd; ks[m * 256 + c + 1] *= kd; }
    __syncthreads();
    const int kq = tid >> 7, v4 = tid & 127;
    f32x4 vv[4];
#pragma unroll
    for (int m = 0; m < 4; ++m) { const u32x2 w = *(const u32x2*)(PROJ + (r0 + m) * NPROJ + 4096 + h * DV + 4 * v4); vv[m] = (f32x4){bflo(w.x), bfhi(w.x), bflo(w.y), bfhi(w.y)}; }
    const float sdec = __builtin_amdgcn_exp2f(4.f * l2g);
    const char* Sin = (const char*)(a.in[5] + ((size_t)(b * RH + h) * DK) * DV);
    char* Sout = (char*)(a.out + O_RS + ((size_t)(b * RH + h) * DK) * DV);
    const unsigned slane = (unsigned)(kq * 64 * DV + 4 * v4) * 4u;
    f32x4 oa[4];
#pragma unroll
    for (int n = 0; n < 4; ++n) oa[n] = (f32x4){0.f, 0.f, 0.f, 0.f};
    f32x4 sa[16], sb[16];
#define SLOAD(buf, g) do { _Pragma("unroll") for (int i = 0; i < 16; ++i) buf[i] = __builtin_nontemporal_load((const f32x4*)(Sin + (size_t)((g) * 16 + i) * DV * 4 + slane)); } while (0)
#define SCOMP(buf, g) do { _Pragma("unroll") for (int i = 0; i < 16; ++i) { const int k = kq * 64 + (g) * 16 + i; \
        _Pragma("unroll") for (int n = 0; n < 4; ++n) oa[n] += buf[i] * qs[n * 256 + k]; \
        f32x4 sn = buf[i] * sdec; \
        _Pragma("unroll") for (int m = 0; m < 4; ++m) sn += vv[m] * ks[m * 256 + k]; \
        __builtin_nontemporal_store(sn, (f32x4*)(Sout + (size_t)((g) * 16 + i) * DV * 4 + slane)); } } while (0)
    SLOAD(sa, 0); SLOAD(sb, 1); SCOMP(sa, 0); SLOAD(sa, 2); SCOMP(sb, 1); SLOAD(sb, 3); SCOMP(sa, 2); SCOMP(sb, 3);
#undef SLOAD
#undef SCOMP
#pragma unroll
    for (int n = 0; n < 4; ++n) *(LAS f32x4*)(red + ((kq * 4 + n) * 512 + 4 * v4)) = oa[n];
    __syncthreads();
    { const int n = tid >> 7;
        f32x4 o = *(LAS f32x4*)(red + ((0 * 4 + n) * 512 + 4 * v4)) + *(LAS f32x4*)(red + ((1 * 4 + n) * 512 + 4 * v4)) + *(LAS f32x4*)(red + ((2 * 4 + n) * 512 + 4 * v4)) + *(LAS f32x4*)(red + ((3 * 4 + n) * 512 + 4 * v4));
        o = o * __builtin_amdgcn_exp2f((float)(n + 1) * l2g);
#pragma unroll
        for (int m = 0; m < 4; ++m) o += vv[m] * scs[n * 4 + m];
        float s1 = (o[0] + o[1]) + (o[2] + o[3]), s2 = (o[0] * o[0] + o[1] * o[1]) + (o[2] * o[2] + o[3] * o[3]);
        s1 = wave_sum(s1); s2 = wave_sum(s2);
        if (lane == 0) { stat[wave * 2] = s1; stat[wave * 2 + 1] = s2; }
        __syncthreads();
        const float t1 = stat[(2 * n) * 2] + stat[(2 * n + 1) * 2], t2 = stat[(2 * n) * 2 + 1] + stat[(2 * n + 1) * 2 + 1];
        const float mu = t1 * (1.f / DV), var = t2 * (1.f / DV) - mu * mu, rstd = __builtin_amdgcn_rsqf(var + EPS);
        const u32x2 gw = *(const u32x2*)(PROJ + (r0 + n) * NPROJ + 8192 + h * DV + 4 * v4);
        u32x2 w; w.x = pk2(bflo(gw.x) * (o[0] - mu) * rstd, bfhi(gw.x) * (o[1] - mu) * rstd); w.y = pk2(bflo(gw.y) * (o[2] - mu) * rstd, bfhi(gw.y) * (o[3] - mu) * rstd);
        *(u32x2*)(OB + (r0 + n) * 4096 + h * DV + 4 * v4) = w;
    }
    __syncthreads();
}

__device__ __forceinline__ void act_fixup(const Args& a, int layer, int pm, int wave_s) {
    LAUNDER_TID();
    if ((pm & 7) == 0 || pm >= MP / 256) return;
    const float* ub = (const float*)(a.ws + WS_UBND); bf16* ACT = (bf16*)(a.ws + WS_ACT);
    const float* cw = a.in[16] + (size_t)layer * 3 * F2; const float* cb = a.in[17] + (size_t)layer * F2;
    for (int g4 = tid; g4 < FF / 4; g4 += NT) {
        const int f = 4 * g4, ug = 256 * (f >> 7) + (f & 127), uu = ug + 128;
        const float* pr = ub + (size_t)((pm - 1) * 4) * F2; const float* cu_ = ub + (size_t)(pm * 4) * F2;
        const f32x4 m2g = *(const f32x4*)(pr + 2 * F2 + ug), m1g = *(const f32x4*)(pr + 3 * F2 + ug), z0g = *(const f32x4*)(cu_ + ug), z1g = *(const f32x4*)(cu_ + F2 + ug);
        const f32x4 m2u = *(const f32x4*)(pr + 2 * F2 + uu), m1u = *(const f32x4*)(pr + 3 * F2 + uu), z0u = *(const f32x4*)(cu_ + uu), z1u = *(const f32x4*)(cu_ + F2 + uu);
        const f32x4 w0g = *(const f32x4*)(cw + f), w1g = *(const f32x4*)(cw + F2 + f), w2g = *(const f32x4*)(cw + 2 * F2 + f), bg = *(const f32x4*)(cb + f);
        const f32x4 w0u = *(const f32x4*)(cw + FF + f), w1u = *(const f32x4*)(cw + F2 + FF + f), w2u = *(const f32x4*)(cw + 2 * F2 + FF + f), bu = *(const f32x4*)(cb + FF + f);
        const f32x4 g0 = w0g * m2g + w1g * m1g + w2g * z0g + bg, u0 = w0u * m2u + w1u * m1u + w2u * z0u + bu;
        const f32x4 g1 = w0g * m1g + w1g * z0g + w2g * z1g + bg, u1 = w0u * m1u + w1u * z0u + w2u * z1u + bu;
        u32x2 o0, o1;
        o0.x = pk2(silu_f(g0[0]) * u0[0], silu_f(g0[1]) * u0[1]); o0.y = pk2(silu_f(g0[2]) * u0[2], silu_f(g0[3]) * u0[3]);
        o1.x = pk2(silu_f(g1[0]) * u1[0], silu_f(g1[1]) * u1[1]); o1.y = pk2(silu_f(g1[2]) * u1[2], silu_f(g1[3]) * u1[3]);
        *(u32x2*)(ACT + (size_t)(pm * 256) * FF + f) = o0; *(u32x2*)(ACT + (size_t)(pm * 256 + 1) * FF + f) = o1;
    }
}

__device__ __forceinline__ void gn_phase(const Args& a, int wave_s) {
    LAUNDER_TID();
    const int G = gridDim.x, gw = blockIdx.x * NWAVES + wave, NGW = G * NWAVES;
    const bf16* PROJ = (const bf16*)(a.ws + WS_PROJ); bf16* OB = (bf16*)(a.ws + WS_OB);
    for (int it0 = gw * 4; it0 < MP * RH; it0 += NGW * 4) {
        u32x4 ov[4], gv[4];
#pragma unroll
        for (int q = 0; q < 4; ++q) { const int it = it0 + q, row = it >> 3, h = it & 7;
            ov[q] = *(const u32x4*)(OB + (size_t)row * 4096 + h * DV + 8 * lane); gv[q] = *(const u32x4*)(PROJ + (size_t)row * NPROJ + 8192 + h * DV + 8 * lane); }
#pragma unroll
        for (int q = 0; q < 4; ++q) { const int it = it0 + q, row = it >> 3, h = it & 7;
            float o[8] = {bflo(ov[q].x), bfhi(ov[q].x), bflo(ov[q].y), bfhi(ov[q].y), bflo(ov[q].z), bfhi(ov[q].z), bflo(ov[q].w), bfhi(ov[q].w)};
            const float g[8] = {bflo(gv[q].x), bfhi(gv[q].x), bflo(gv[q].y), bfhi(gv[q].y), bflo(gv[q].z), bfhi(gv[q].z), bflo(gv[q].w), bfhi(gv[q].w)};
            float s1 = 0.f, s2 = 0.f;
#pragma unroll
            for (int e = 0; e < 8; ++e) { s1 += o[e]; s2 += o[e] * o[e]; }
            s1 = wave_sum(s1); s2 = wave_sum(s2);
            const float mu = s1 * (1.f / DV), var = s2 * (1.f / DV) - mu * mu, rstd = __builtin_amdgcn_rsqf(var + EPS);
#pragma unroll
            for (int e = 0; e < 8; ++e) o[e] = g[e] * (o[e] - mu) * rstd;
            u32x4 w; w.x = pk2(o[0], o[1]); w.y = pk2(o[2], o[3]); w.z = pk2(o[4], o[5]); w.w = pk2(o[6], o[7]);
            *(u32x4*)(OB + (size_t)row * 4096 + h * DV + 8 * lane) = w; }
    }
}

__device__ __forceinline__ void final_phase(const Args& a, const bf16* xs, const float* ssq, int wave_s) {
    LAUNDER_TID();
    const int G = gridDim.x, gw = blockIdx.x * NWAVES + wave, NGW = G * NWAVES;
    const float* gf = a.in[10];
    for (int row = gw; row < M; row += NGW) {
        const float rs = row_rstd(ssq, row);
#pragma unroll
        for (int j = 0; j < 4; ++j) { const int c = 8 * lane + 512 * j; const u32x4 w = *(const u32x4*)(xs + (size_t)row * D + c);
            const f32x4 g0 = *(const f32x4*)(gf + c), g1 = *(const f32x4*)(gf + c + 4);
            *(f32x4*)(a.out + (size_t)row * D + c) = (f32x4){bflo(w.x), bfhi(w.x), bflo(w.y), bfhi(w.y)} * rs * g0;
            *(f32x4*)(a.out + (size_t)row * D + c + 4) = (f32x4){bflo(w.z), bfhi(w.z), bflo(w.w), bfhi(w.w)} * rs * g1; }
    }
}

constexpr int NPH = 15;
__global__ void __launch_bounds__(NT, 2) fwd_kernel(Args args) {
    extern __shared__ __attribute__((aligned(16))) unsigned char lds_raw[];
    LAS unsigned char* lds = (LAS unsigned char*)lds_raw;
    const int tid = threadIdx.x;
    const int wave_s = __builtin_amdgcn_readfirstlane(tid >> 6);
    const int G = gridDim.x;
    unsigned char* ws = args.ws;
    for (int u = tid; u < (LDS_BYTES - LDSCTL_OFF) / 4; u += NT) ((LAS unsigned*)(lds + LDSCTL_OFF))[u] = 0u;
    __syncthreads();
    XcdBarrier bar; bar.bar = (unsigned*)(ws + WS_CTL) + CW_BAR; bar.x = 0; bar.st = nullptr;
    const int lo = args.ph_lo, hi = args.ph_hi;
    if (hi - lo > 1) bar = xcd_barrier_post((unsigned*)(ws + WS_CTL) + CW_BAR, (volatile LAS unsigned*)(lds + MISC_OFF) + 8);
#define IN(k) (lo <= (k) && (k) < hi)
#define SEAM(k) do { if (IN(k) && IN((k) + 1)) xcd_barrier(bar, wave_s); } while (0)
#define SEAM2(k, k2) do { if (IN(k) && IN(k2)) xcd_barrier(bar, wave_s); } while (0)
    float* XSA = (float*)(ws + WS_XSA); float* XSB = (float*)(ws + WS_XSB);
    bf16* XB0 = (bf16*)(ws + WS_XB0); bf16* XB1 = (bf16*)(ws + WS_XB1);
#define SSQV(k) ((float*)(ws + WS_SSQV + (k) * SSQV_STRIDE))
#define SSQO(k) SSQV(rep_ ? 6 : (k))
    pg8::StaticOrder S;

    if (IN(0)) REP(0) { p0_prologue(args, lds, wave_s); }
    SEAM(0);
#define GEMM_RUN(XT, EPI, ...) do { S.init((XT) ? MP : M, NN_, G, (int)blockIdx.x); const pg8::EPI e_ __VA_ARGS__; const pg8::EpiDrive<pg8::EPI> E(e_); pg8::gemm_phase<pg8::EpiDrive<pg8::EPI>, XT>(lds, g, S, E, wave_s); } while (0)
#define EMB_FILL(l) do { const int nu_ = (M / 256) * (F2 / 256), r_ = (nu_ + G - 1) / G, ns_ = r_ * G - nu_; \
        pg8::Gemm g{(const bf16*)(ws + WS_PB) + (size_t)(l) * M * PLE, (const bf16*)(ws + WS_WP) + (size_t)(l) * D * PLE, PLE, PLE, 0}; \
        if (ns_ > 0) S.init(MP, D, ns_, (int)blockIdx.x - (G - ns_)); else S.init(MP, D, G, (int)blockIdx.x); \
        const pg8::EpiBf16 e_{(bf16*)(ws + ((l) ? WS_EMB1 : WS_EMB0)), nullptr}; const pg8::EpiDrive<pg8::EpiBf16> E(e_); pg8::gemm_phase<pg8::EpiDrive<pg8::EpiBf16>, true>(lds, g, S, E, wave_s); } while (0)
    if (IN(1)) REP(1) {
        { constexpr int NN_ = D; pg8::Gemm g{(const bf16*)(ws + WS_DPRE), (const bf16*)(ws + WS_WPOOL), D, 512, 2}; GEMM_RUN(true, EpiRes, {args.in[0], args.in[1], nullptr, XB0, SSQO(0), args.in[12], nullptr}); }
    }
    SEAM(1);
    if (IN(2)) REP(2) { constexpr int NN_ = F2; pg8::Gemm g{XB0, (const bf16*)(ws + WS_WUP), D, D, 0}; S.init(M, NN_, G, (int)blockIdx.x); const pg8::EpiUpAct E{(bf16*)(ws + WS_ACT), SSQV(0), args.out + O_CP, args.out + O_CS, args.in[16], args.in[17], args.in[6], (float*)(ws + WS_UBND), (LAS float*)(lds + XCH_OFF)}; pg8::gemm_phase<pg8::EpiUpAct, false>(lds, g, S, E, wave_s); }
    if (IN(2)) EMB_FILL(0);
#if defined(PROBE_VAR)
    if (IN(2)) { pg8::Gemm g{XB0, (const bf16*)(ws + WS_WUP), D, D, 0}; S.init(M, F2, G, (int)blockIdx.x); const pg8::EpiBf16 e_{(bf16*)(ws + WS_U + 16 * MiB), nullptr}; const pg8::EpiDrive<pg8::EpiBf16> E(e_); pg8::gemm_phase<pg8::EpiDrive<pg8::EpiBf16>, false, PROBE_VAR>(lds, g, S, E, wave_s); }
#endif
    SEAM2(2, 4);
    if (IN(4)) REP(4) { constexpr int NN_ = D; { pg8::Unit u_; S.init(MP, D, G, (int)blockIdx.x); for (int i = 0; S.next(i, u_); ++i) act_fixup(args, 0, u_.pm, wave_s); asm volatile("s_waitcnt vmcnt(0)" ::: "memory"); __syncthreads(); }
        pg8::Gemm g{(const bf16*)(ws + WS_ACT), (const bf16*)(ws + WS_WDN), FF, FF, 0}; GEMM_RUN(true, EpiRes, {nullptr, nullptr, XB0, XB1, SSQO(1), nullptr, nullptr}); }
    SEAM(4);
    if (IN(5)) REP(5) { constexpr int NN_ = D; pg8::Gemm g{XB1, (const bf16*)(ws + WS_WG), D, D, 0}; GEMM_RUN(true, EpiPle, {XB1, (const bf16*)(ws + WS_EMB0), SSQV(1), XB0, SSQO(2)}); }
    SEAM(5);
    if (IN(6)) REP(6) { constexpr int NN_ = NPROJ; pg8::Gemm g{XB0, (const bf16*)(ws + WS_WIN), D, D, 0}; GEMM_RUN(true, EpiRetIn, {(bf16*)(ws + WS_PROJ), SSQV(2), (const float*)(ws + WS_ROPE)}); }
    SEAM(6);
    if (IN(7)) REP(7) {
        const int bx = blockIdx.x, half = (bx >> 3) & 1, rank = (bx >> 4) * 8 + (bx & 7), nh = G / 2;
        if (G % 16 != 0) { for (int it = bx; it < NB * RH * 8; it += G) ret_prompt_item(args, lds, it, wave_s); __syncthreads(); for (int it = bx; it < DB * RH; it += G) ret_sample_item(args, lds, it, wave_s); }
        else if (half == 0) {
            const int prank = (G == 256) ? (((bx & 7) * 2 + (bx >> 7)) * 8 + ((bx >> 4) & 7)) : rank;
            REP(16) for (int it = prank; it < NB * RH * 8; it += nh) ret_prompt_item(args, lds, it, wave_s); }
        else { REP(17) for (int it = rank; it < DB * RH; it += nh) ret_sample_item(args, lds, it, wave_s); }
    }
    SEAM(7);
    if (IN(8)) gn_phase(args, wave_s);
    SEAM(8);
    if (IN(9)) REP(9) { constexpr int NN_ = D; pg8::Gemm g{(const bf16*)(ws + WS_OB), (const bf16*)(ws + WS_WOUT), 4096, 4096, 0}; GEMM_RUN(true, EpiRes, {nullptr, nullptr, XB0, XB1, SSQO(3), nullptr, nullptr}); }
    SEAM(9);
    if (IN(10)) REP(10) { constexpr int NN_ = F2; pg8::Gemm g{XB1, (const bf16*)(ws + WS_WUP) + (size_t)F2 * D, D, D, 0}; S.init(M, NN_, G, (int)blockIdx.x); const pg8::EpiUpAct E{(bf16*)(ws + WS_ACT), SSQV(3), args.out + O_CP + (size_t)NB * 2 * F2, args.out + O_CS + (size_t)DB * 2 * F2, args.in[16] + (size_t)3 * F2, args.in[17] + F2, args.in[6] + (size_t)DB * 2 * F2, (float*)(ws + WS_UBND), (LAS float*)(lds + XCH_OFF)}; pg8::gemm_phase<pg8::EpiUpAct, false>(lds, g, S, E, wave_s); }
    if (IN(10)) EMB_FILL(1);
    SEAM2(10, 12);
    if (IN(12)) REP(12) { constexpr int NN_ = D; { pg8::Unit u_; S.init(MP, D, G, (int)blockIdx.x); for (int i = 0; S.next(i, u_); ++i) act_fixup(args, 1, u_.pm, wave_s); asm volatile("s_waitcnt vmcnt(0)" ::: "memory"); __syncthreads(); }
        pg8::Gemm g{(const bf16*)(ws + WS_ACT), (const bf16*)(ws + WS_WDN) + (size_t)D * FF, FF, FF, 0}; GEMM_RUN(true, EpiRes, {nullptr, nullptr, XB1, XB0, SSQO(4), nullptr, nullptr}); }
    SEAM(12);
    const bool fuse_fin = (G == (MP / 256) * (D / 256));
    if (IN(13)) { constexpr int NN_ = D; pg8::Gemm g{XB0, (const bf16*)(ws + WS_WG) + (size_t)D * D, D, D, 0};
        if (fuse_fin) { S.init(MP, NN_, G, (int)blockIdx.x);
            const pg8::EpiPleFin E{XB0, (const bf16*)(ws + WS_EMB1), SSQV(4), SSQV(5), args.in[10], args.out, (unsigned*)(ws + WS_CTL) + CW_PCNT, (unsigned*)(ws + WS_CTL)};
            pg8::gemm_phase<pg8::EpiPleFin, true>(lds, g, S, E, wave_s); }
        else { const int rep_ = 0; (void)rep_; GEMM_RUN(true, EpiPle, {XB0, (const bf16*)(ws + WS_EMB1), SSQV(4), XB1, SSQV(5)}); } }
    if (!fuse_fin) { SEAM(13);
        if (IN(14)) final_phase(args, XB1, SSQV(5), wave_s); }
#undef IN
#undef SEAM
}

extern "C" void kernel_launch(void* const* d_in, const int* in_sizes, int n_in, void* d_out, int out_size, void* d_ws, size_t ws_size, hipStream_t stream) {
    static int grid = 0;
    if (grid == 0) {
        if (n_in != 21 || (size_t)out_size != O_END || ws_size < WS_END) { fprintf(stderr, "kernel_launch: unexpected sizes n_in %d out %d ws %zu\n", n_in, out_size, ws_size); grid = -1; return; }
        int dev = 0, cus = 0, per_cu = 0;
        if (hipGetDevice(&dev) != hipSuccess || hipDeviceGetAttribute(&cus, hipDeviceAttributeMultiprocessorCount, dev) != hipSuccess) { grid = -1; return; }
        if (hipFuncSetAttribute((const void*)fwd_kernel, hipFuncAttributeMaxDynamicSharedMemorySize, LDS_BYTES) != hipSuccess) { fprintf(stderr, "kernel_launch: hipFuncSetAttribute failed\n"); grid = -1; return; }
        if (hipOccupancyMaxActiveBlocksPerMultiprocessor(&per_cu, (const void*)fwd_kernel, NT, LDS_BYTES) != hipSuccess || per_cu < 1) { fprintf(stderr, "kernel_launch: occupancy query says %d\n", per_cu); }
        (void)hipGetLastError();
        grid = cus;
    }
    if (grid < 0) return;
    if (hipMemsetAsync((char*)d_ws + WS_CTL, 0, CTL_ZERO_BYTES, stream) != hipSuccess) return;
    Args a{};
    for (int i = 0; i < 21; ++i) a.in[i] = (const float*)d_in[i];
    a.out = (float*)d_out; a.ws = (unsigned char*)d_ws;
#if MK_ONE_LAUNCH
    a.ph_lo = 0; a.ph_hi = NPH;
    hipLaunchKernelGGL(fwd_kernel, dim3(grid), dim3(NT), LDS_BYTES, stream, a);
#else
    for (int p = 0; p < NPH; ++p) { a.ph_lo = p; a.ph_hi = p + 1; hipLaunchKernelGGL(fwd_kernel, dim3(grid), dim3(NT), LDS_BYTES, stream, a); }
#endif
}
```

```cpp
#include <hip/hip_runtime.h>
#include <cstdio>
#include <cstdint>

#ifndef MK_ONE_LAUNCH
#define MK_ONE_LAUNCH 1
#endif

#ifndef PROBE_DUP
#define PROBE_DUP 0
#endif
#define REP(k) _Pragma("unroll") for (int rep_ = 0; rep_ < 1 + ((PROBE_DUP >> (k)) & 1); ++rep_)
#define LAS __attribute__((address_space(3)))
#define GAS __attribute__((address_space(1)))
typedef unsigned short bf16;
typedef short bf16x8 __attribute__((ext_vector_type(8)));
typedef short s16x4 __attribute__((ext_vector_type(4)));
typedef float f32x4 __attribute__((ext_vector_type(4)));
typedef float f32x2 __attribute__((ext_vector_type(2)));
typedef unsigned u32x4 __attribute__((ext_vector_type(4)));
typedef unsigned u32x2 __attribute__((ext_vector_type(2)));
typedef GAS unsigned gu32;

constexpr int D = 2048, NB = 4, SEQ = 2048, DB = 128, DS = 4;
constexpr int MP = NB * SEQ, MS = DB * DS, M = MP + MS;
constexpr int FF = 5632, F2 = 2 * FF, PLE = 256;
constexpr int RH = 8, DK = 256, DV = 512, NPROJ = 12288;
constexpr int PBUF = 15, PAST = 16384, NPOS = SEQ + DS;
constexpr float EPS = 1e-6f;
constexpr int NWAVES = 8, NT = NWAVES * 64;

constexpr size_t O_YP = 0, O_YS = (size_t)MP * D, O_PP = O_YS + (size_t)MS * D, O_PS = O_PP + (size_t)NB * PBUF * D,
                 O_RP = O_PS + (size_t)DB * PBUF * D, O_RS = O_RP + (size_t)NB * RH * DK * DV, O_CP = O_RS + (size_t)DB * RH * DK * DV,
                 O_CS = O_CP + (size_t)2 * NB * 2 * F2, O_END = O_CS + (size_t)2 * DB * 2 * F2;

constexpr size_t MiB = 1u << 20;
constexpr size_t WS_CTL = 0, CTL_ZERO_BYTES = 1 * MiB;
constexpr size_t WS_ROPE = 2 * MiB;
constexpr size_t WS_SSQV = 65536, SSQV_STRIDE = 36864;
constexpr size_t WS_WPOOL = 16 * MiB;
constexpr size_t WS_WP = 18 * MiB;
constexpr size_t WS_WG = 20 * MiB;
constexpr size_t WS_WUP = 36 * MiB;
constexpr size_t WS_WDN = 124 * MiB;
constexpr size_t WS_WIN = 168 * MiB;
constexpr size_t WS_WOUT = 216 * MiB;
constexpr size_t WS_PB = 240 * MiB;
constexpr size_t WS_DPRE = 250 * MiB;
constexpr size_t WS_EMB0 = 284 * MiB, WS_EMB1 = 318 * MiB;
constexpr size_t WS_XSA = 352 * MiB, WS_XSB = 420 * MiB;
constexpr size_t WS_XB0 = 488 * MiB, WS_XB1 = 522 * MiB;
constexpr size_t WS_U = 560 * MiB;
constexpr size_t WS_UBND = 560 * MiB;
constexpr size_t WS_ACT = 748 * MiB;
constexpr size_t WS_PROJ = 842 * MiB;
constexpr size_t WS_OB = 1046 * MiB;
constexpr size_t WS_END = 1114 * MiB;
static_assert(WS_WPOOL + (size_t)2048 * 512 * 2 <= WS_WP && WS_WP + (size_t)2 * 2048 * 256 * 2 <= WS_WG && WS_WG + (size_t)2 * 2048 * 2048 * 2 <= WS_WUP &&
              WS_WUP + (size_t)2 * F2 * D * 2 <= WS_WDN && WS_WDN + (size_t)2 * D * FF * 2 <= WS_WIN && WS_WIN + (size_t)NPROJ * D * 2 <= WS_WOUT && WS_WOUT + (size_t)D * 4096 * 2 <= WS_PB, "ws weights");
static_assert(WS_PB + (size_t)2 * M * PLE * 2 <= WS_DPRE && WS_DPRE + (size_t)M * D * 2 <= WS_EMB0 && WS_EMB0 + (size_t)M * D * 2 <= WS_EMB1 && WS_EMB1 + (size_t)M * D * 2 <= WS_XSA &&
              WS_XSA + (size_t)M * D * 4 <= WS_XSB && WS_XSB + (size_t)M * D * 4 <= WS_XB0 && WS_XB0 + (size_t)M * D * 2 <= WS_XB1 && WS_XB1 + (size_t)M * D * 2 <= WS_U &&
              WS_U + (size_t)M * F2 * 2 <= WS_ACT && WS_ACT + (size_t)M * FF * 2 <= WS_PROJ && WS_PROJ + (size_t)M * NPROJ * 2 <= WS_OB && WS_OB + (size_t)M * 4096 * 2 <= WS_END, "ws activations");
static_assert(WS_ROPE + (size_t)2 * NPOS * 128 * 4 <= WS_WPOOL && WS_SSQV + 7 * SSQV_STRIDE <= CTL_ZERO_BYTES && (size_t)M * 4 <= SSQV_STRIDE, "ws tables");
constexpr int CW_BAR = 4096, CW_PCNT = 8192;

constexpr int RING_BYTES = 131072, XA_BYTES = 4096, LDSCTL_OFF = RING_BYTES + XA_BYTES, MISC_OFF = LDSCTL_OFF + 320, XCH_OFF = LDSCTL_OFF + 1024, XCH_BYTES = 8192, LDS_BYTES = 147456;

__device__ __forceinline__ unsigned f2bf(float f) { unsigned u = __builtin_bit_cast(unsigned, f); return (u + 0x7fffu + ((u >> 16) & 1u)) >> 16; }
__device__ __forceinline__ unsigned pk2(float lo, float hi) { unsigned r; asm("v_cvt_pk_bf16_f32 %0, %1, %2" : "=v"(r) : "v"(lo), "v"(hi)); return r; }
__device__ __forceinline__ float bflo(unsigned w) { return __builtin_bit_cast(float, w << 16); }
__device__ __forceinline__ float bfhi(unsigned w) { return __builtin_bit_cast(float, w & 0xffff0000u); }
__device__ __forceinline__ float wave_sum(float v) {
#pragma unroll
    for (int o = 1; o < 64; o <<= 1) v += __shfl_xor(v, o);
    return v;
}
__device__ __forceinline__ float gamma_l2(int h) {
    float v = -4.580368961e-02f;
    v = (h == 1) ? -2.272007650e-02f : v; v = (h == 2) ? -1.131531323e-02f : v; v = (h == 3) ? -5.646563141e-03f : v; v = (h == 4) ? -2.820519062e-03f : v;
    v = (h == 5) ? -1.409570255e-03f : v; v = (h == 6) ? -7.046129766e-04f : v; v = (h == 7) ? -3.522634716e-04f : v;
    return v;
}
__device__ __forceinline__ float silu_f(float x) { return x * __builtin_amdgcn_rcpf(1.f + __expf(-x)); }
__device__ __forceinline__ float sigmoid_f(float x) { return __builtin_amdgcn_rcpf(1.f + __expf(-x)); }
__device__ __forceinline__ float row_rstd(const float* ssq, int row) { return __builtin_amdgcn_rsqf(ssq[row] * (1.f / D) + EPS); }

namespace pg8 {
constexpr int BM = 256, BK = 64, HALF = 128, HTB = HALF * BK * 2, STAGE_BYTES = 8 * HTB, NXCD = 8, WGM = 8;
__host__ __device__ __forceinline__ int lds_byte(int r, int c) { const int st = (r >> 4) * 2 + (c >> 5), rr = r & 15, cc = c & 31, ob = rr * 64 + cc * 2; return st * 1024 + (ob ^ (((ob >> 9) & 1) << 5)); }
__host__ __device__ __forceinline__ void stage_rc(int b, int& R, int& C) { const int st = b / 1024, sb = b % 1024, swz = sb ^ (((sb >> 9) & 1) << 5); R = (st >> 1) * 16 + swz / 64; C = (st & 1) * 32 + (swz % 64) / 2; }
__host__ __device__ __forceinline__ int perm32(int rho) { const int n = rho >> 4, i = rho & 15; return 8 * (i >> 2) + 4 * n + (i & 3); }
struct Unit { int pm, pn; };
struct Gemm { const bf16* A; const bf16* Bt; int lda, K, grp; };
struct StaticOrder {
    int nM, nN, nwg, G, c;
    __host__ __device__ __forceinline__ void init(int M_, int N_, int G_, int c_) { nM = M_ / BM; nN = N_ / BM; nwg = nM * nN; G = G_; c = c_; }
    __host__ __device__ __forceinline__ bool next(int i, Unit& u) const {
        if (c < 0) return false;
        const long L = (long)i * G + c; if (L >= nwg) return false;
        int wgid = (int)L; { const int q = nwg / NXCD, r = nwg % NXCD, xcd = wgid % NXCD, off = wgid / NXCD; wgid = (xcd < r ? xcd * (q + 1) : r * (q + 1) + (xcd - r) * q) + off; }
        const int nig = WGM * nN, gid = wgid / nig, fm = gid * WGM, gsz = (nM - fm) < WGM ? (nM - fm) : WGM;
        u.pm = fm + ((wgid % nig) % gsz); u.pn = (wgid % nig) / gsz; return true;
    }
};
template <class Epi, bool XT, int VAR = 0>
__device__ __forceinline__ void gemm_phase(LAS unsigned char* lds, const Gemm g, const StaticOrder& S, const Epi& E, int wave_s) {
    const int wid = __builtin_amdgcn_readfirstlane(wave_s); int lane = (int)__builtin_amdgcn_mbcnt_hi(~0u, __builtin_amdgcn_mbcnt_lo(~0u, 0u)); asm volatile("" : "+v"(lane));
    const int tid = wid * 64 + lane, wr = wid >> 2, wc = wid & 3, fr = lane & 15, fq = lane >> 4;
    int K = g.K, lda = g.lda; asm volatile("" : "+s"(K), "+s"(lda));
    const int nt = K / BK;
    unsigned voffA[2], voffB[2], voffX = 0;
#pragma unroll
    for (int i = 0; i < 2; ++i) { int R, C; stage_rc(tid * 16 + i * 8192, R, C); const int Rb = (R & ~31) + perm32(R & 31);
        voffA[i] = (unsigned)(R * lda + C) * 2u; voffB[i] = (unsigned)(Rb * K + C) * 2u; }
    if (XT) { int R, C; stage_rc(wid * 256 + fr * 16, R, C); voffX = (unsigned)(R * lda + C) * 2u; }
    const unsigned kstep = (unsigned)(BK * 2);
    const unsigned hA = (unsigned)HALF * lda * 2, hB = (unsigned)HALF * K * 2, tA = 2 * hA, tB = 2 * hB, tX = (unsigned)16 * lda * 2, xbase = (unsigned)MP * lda * 2;
    const __amdgpu_buffer_rsrc_t rsA = __builtin_amdgcn_make_buffer_rsrc((void*)g.A, 0, 0xFFFFFFF0u, 0x00020000), rsB = __builtin_amdgcn_make_buffer_rsrc((void*)g.Bt, 0, 0xFFFFFFF0u, 0x00020000);
    const unsigned ldsw = (unsigned)wid * 1024u;
    const int aoff = lds_byte(wr * 64 + fr, fq * 8), boff = lds_byte(wc * 32 + fr, fq * 8), xoff = lds_byte(fr, fq * 8);
#define PG8_SA(b, h) (((b) * 2 + (h)) * HTB)
#define PG8_SB(b, h) ((4 + (b) * 2 + (h)) * HTB)
#define PG8_XA(b) (STAGE_BYTES + (b) * 2048)
#define PG8_STAGE(bufoff, rs, soff, voff) do { if constexpr (VAR != 3) _Pragma("unroll") for (int _i = 0; _i < 2; ++_i) \
        __builtin_amdgcn_raw_ptr_buffer_load_lds(rs, (LAS unsigned*)(lds + (bufoff) + ldsw + _i * 8192), 16, (voff)[_i], (soff), 0, 0); } while (0)
#define PG8_STAGEX(b, soff) do { if constexpr (XT) { if (lane < 16) \
        __builtin_amdgcn_raw_ptr_buffer_load_lds(rsA, (LAS unsigned*)(lds + PG8_XA(b) + wid * 256), 16, voffX, (soff), 0, 0); } } while (0)
#define PG8_LDA(dst, b, h) do { if constexpr (VAR != 1) _Pragma("unroll") for (int m = 0; m < 4; ++m) _Pragma("unroll") for (int k = 0; k < 2; ++k) dst[m][k] = *(const LAS bf16x8*)(lds + PG8_SA(b, h) + aoff + m * 2048 + k * 1024); } while (0)
#define PG8_LDB(dst, b, h) do { if constexpr (VAR != 1) _Pragma("unroll") for (int n = 0; n < 2; ++n) _Pragma("unroll") for (int k = 0; k < 2; ++k) dst[n][k] = *(const LAS bf16x8*)(lds + PG8_SB(b, h) + boff + n * 2048 + k * 1024); } while (0)
#define PG8_LDX(b) do { if constexpr (XT) { _Pragma("unroll") for (int k = 0; k < 2; ++k) Ax[k] = *(const LAS bf16x8*)(lds + PG8_XA(b) + xoff + k * 1024); } } while (0)
#define PG8_MMA(ai, bj, At, Bt) do { if constexpr (VAR < 4 || VAR == 9) __builtin_amdgcn_s_setprio(1); \
        if constexpr (VAR == 9) { _Pragma("unroll") for (int m = 0; m < 4; ++m) _Pragma("unroll") for (int k = 0; k < 2; ++k) acc32[ai][bj][m >> 1] = __builtin_amdgcn_mfma_f32_32x32x16_bf16(Bt[m & 1][k], At[m][k], acc32[ai][bj][m >> 1], 0, 0, 0); } \
        else if constexpr (VAR != 2) _Pragma("unroll") for (int m = 0; m < 4; ++m) _Pragma("unroll") for (int n = 0; n < 2; ++n) _Pragma("unroll") for (int k = 0; k < 2; ++k) \
        acc[ai][bj][m][n] = __builtin_amdgcn_mfma_f32_16x16x32_bf16(Bt[n][k], At[m][k], acc[ai][bj][m][n], 0, 0, 0); if constexpr (VAR < 4 || VAR == 9) __builtin_amdgcn_s_setprio(0); } while (0)
#define PG8_MMAX() do { if constexpr (XT) { if (wr == 0) { _Pragma("unroll") for (int k = 0; k < 2; ++k) { accx[0] = __builtin_amdgcn_mfma_f32_16x16x32_bf16(B0[0][k], Ax[k], accx[0], 0, 0, 0); accx[1] = __builtin_amdgcn_mfma_f32_16x16x32_bf16(B1[0][k], Ax[k], accx[1], 0, 0, 0); } } \
        else { _Pragma("unroll") for (int k = 0; k < 2; ++k) { accx[0] = __builtin_amdgcn_mfma_f32_16x16x32_bf16(B0[1][k], Ax[k], accx[0], 0, 0, 0); accx[1] = __builtin_amdgcn_mfma_f32_16x16x32_bf16(B1[1][k], Ax[k], accx[1], 0, 0, 0); } } } } while (0)
#define PG8_WAIT_V(n) asm volatile("s_waitcnt vmcnt(" #n ")" ::: "memory")
#define PG8_WAIT_VL() do { if constexpr (XT) PG8_WAIT_V(9); else PG8_WAIT_V(8); } while (0)
#define PG8_WAIT_L(n) asm volatile("s_waitcnt lgkmcnt(" #n ")" ::: "memory")
#define PG8_BAR __builtin_amdgcn_s_barrier()
#define PG8_SCHED __builtin_amdgcn_sched_barrier(0)
    Unit cur, nxt; int ui = 0;
    if (!S.next(0, cur)) return;
    if constexpr (VAR == 5) { if (wr == 1) __builtin_amdgcn_s_setprio(1); }
    f32x4 acc[2][2][4][2]; f32x4 accx[2];
    typedef float f32x16 __attribute__((ext_vector_type(16)));
    f32x16 acc32[2][2][2];
    if constexpr (VAR == 9) { _Pragma("unroll") for (int a_ = 0; a_ < 2; ++a_) _Pragma("unroll") for (int b_ = 0; b_ < 2; ++b_) _Pragma("unroll") for (int c_ = 0; c_ < 2; ++c_) _Pragma("unroll") for (int e_ = 0; e_ < 16; ++e_) acc32[a_][b_][c_][e_] = 0.f; }
#pragma unroll
    for (int a = 0; a < 2; ++a)
#pragma unroll
        for (int b = 0; b < 2; ++b)
#pragma unroll
            for (int m = 0; m < 4; ++m)
#pragma unroll
                for (int n = 0; n < 2; ++n) acc[a][b][m][n] = (f32x4){0.f, 0.f, 0.f, 0.f};
    accx[0] = (f32x4){0.f, 0.f, 0.f, 0.f}; accx[1] = (f32x4){0.f, 0.f, 0.f, 0.f};
    bf16x8 At[4][2], B0[2][2], B1[2][2], Ax[2];
    if constexpr (VAR == 1) { const bf16x8 z_ = (bf16x8){(short)lane, 1, 2, 3, 4, 5, 6, 7};
        _Pragma("unroll") for (int m = 0; m < 4; ++m) { At[m][0] = z_; At[m][1] = z_; } _Pragma("unroll") for (int n = 0; n < 2; ++n) { B0[n][0] = z_; B0[n][1] = z_; B1[n][0] = z_; B1[n][1] = z_; } }
    const unsigned acol0 = g.grp ? (unsigned)(cur.pn / g.grp) * K * 2 : 0u;
    unsigned cA = (unsigned)cur.pm * tA + acol0, cB = (unsigned)cur.pn * tB, cX = xbase + (unsigned)cur.pm * tX + acol0;
    PG8_STAGE(PG8_SB(0, 0), rsB, cB, voffB); PG8_STAGE(PG8_SB(0, 1), rsB, cB + hB, voffB); PG8_STAGE(PG8_SA(0, 0), rsA, cA, voffA); PG8_STAGEX(0, cX); PG8_STAGE(PG8_SA(0, 1), rsA, cA + hA, voffA);
    if (wr == 1) PG8_BAR;
    PG8_WAIT_V(2); PG8_BAR;
    PG8_STAGE(PG8_SB(1, 0), rsB, cB + kstep, voffB); PG8_STAGE(PG8_SA(1, 0), rsA, cA + kstep, voffA); PG8_STAGE(PG8_SB(1, 1), rsB, cB + hB + kstep, voffB); PG8_STAGEX(1, cX + kstep);
    if constexpr (XT) PG8_WAIT_V(7); else PG8_WAIT_V(6);
    PG8_BAR;
    for (;;) {
        const bool has_next = S.next(ui + 1, nxt);
        const unsigned acoln = (has_next && g.grp) ? (unsigned)(nxt.pn / g.grp) * K * 2 : 0u;
        const unsigned nA = has_next ? (unsigned)nxt.pm * tA + acoln : cA;
        const unsigned nB = has_next ? (unsigned)nxt.pn * tB : cB;
        const unsigned nX = has_next ? xbase + (unsigned)nxt.pm * tX + acoln : cX;
        for (int t = 0; t < nt; t += 2) {
            const bool last = (t == nt - 2);
            const unsigned a1 = cA + (unsigned)(t + 1) * kstep;
            const unsigned a2 = last ? nA : cA + (unsigned)(t + 2) * kstep, b2 = last ? nB : cB + (unsigned)(t + 2) * kstep, x2 = last ? nX : cX + (unsigned)(t + 2) * kstep;
            const unsigned a3 = a2 + kstep, b3 = b2 + kstep, x3 = x2 + kstep;
            PG8_LDB(B0, 0, 0); PG8_LDB(B1, 0, 1); PG8_SCHED; PG8_LDA(At, 0, 0); PG8_LDX(0); PG8_STAGE(PG8_SA(1, 1), rsA, a1 + hA, voffA);
            PG8_WAIT_VL(); PG8_WAIT_L(0); PG8_BAR; PG8_MMA(0, 0, At, B0); PG8_MMA(0, 1, At, B1); PG8_MMAX(); PG8_BAR; PG8_SCHED;
            PG8_LDA(At, 0, 1); PG8_STAGE(PG8_SB(0, 0), rsB, b2, voffB); PG8_STAGE(PG8_SB(0, 1), rsB, b2 + hB, voffB); PG8_STAGE(PG8_SA(0, 0), rsA, a2, voffA); PG8_STAGEX(0, x2);
            PG8_WAIT_VL(); PG8_WAIT_L(0); PG8_BAR; PG8_MMA(1, 0, At, B0); PG8_MMA(1, 1, At, B1); PG8_BAR; PG8_SCHED;
            PG8_LDB(B0, 1, 0); PG8_LDB(B1, 1, 1); PG8_SCHED; PG8_LDA(At, 1, 0); PG8_LDX(1); PG8_STAGE(PG8_SA(0, 1), rsA, a2 + hA, voffA);
            PG8_WAIT_VL(); PG8_WAIT_L(0); PG8_BAR; PG8_MMA(0, 0, At, B0); PG8_MMA(0, 1, At, B1); PG8_MMAX(); PG8_BAR; PG8_SCHED;
            PG8_LDA(At, 1, 1); PG8_STAGE(PG8_SB(1, 0), rsB, b3, voffB); PG8_STAGE(PG8_SB(1, 1), rsB, b3 + hB, voffB); PG8_STAGE(PG8_SA(1, 0), rsA, a3, voffA); PG8_STAGEX(1, x3);
            PG8_WAIT_VL(); PG8_WAIT_L(0); PG8_BAR; PG8_MMA(1, 0, At, B0); PG8_MMA(1, 1, At, B1); PG8_BAR; PG8_SCHED;
        }
        if (wr == 0) PG8_BAR;
        if constexpr (VAR == 9) { _Pragma("unroll") for (int a_ = 0; a_ < 2; ++a_) _Pragma("unroll") for (int b_ = 0; b_ < 2; ++b_) _Pragma("unroll") for (int c_ = 0; c_ < 2; ++c_) _Pragma("unroll") for (int e_ = 0; e_ < 16; ++e_) { acc[a_][b_][2 * c_ + (e_ >> 3)][(e_ >> 2) & 1][e_ & 3] = acc32[a_][b_][c_][e_]; acc32[a_][b_][c_][e_] = 0.f; } }
        E.tile(acc, cur, wr, wc, fr, fq);
        if constexpr (XT) E.strip(accx, cur, wr, wc, fr, fq);
        if constexpr (Epi::FIN) E.finish(acc, accx, cur, wr, wc, fr, fq, wid);
        if (!has_next) break;
#pragma unroll
        for (int a = 0; a < 2; ++a)
#pragma unroll
            for (int b = 0; b < 2; ++b)
#pragma unroll
                for (int m = 0; m < 4; ++m)
#pragma unroll
                    for (int n = 0; n < 2; ++n) acc[a][b][m][n] = (f32x4){0.f, 0.f, 0.f, 0.f};
        accx[0] = (f32x4){0.f, 0.f, 0.f, 0.f}; accx[1] = (f32x4){0.f, 0.f, 0.f, 0.f};
        cur = nxt; cA = nA; cB = nB; cX = nX; ++ui;
        if (wr == 1) PG8_BAR;
    }
    PG8_WAIT_V(0);
    PG8_BAR;
    if constexpr (VAR == 5) __builtin_amdgcn_s_setprio(0);
#undef PG8_SA
#undef PG8_SB
#undef PG8_XA
#undef PG8_STAGE
#undef PG8_STAGEX
#undef PG8_LDA
#undef PG8_LDB
#undef PG8_LDX
#undef PG8_MMA
#undef PG8_MMAX
#undef PG8_WAIT_V
#undef PG8_WAIT_VL
#undef PG8_WAIT_L
#undef PG8_BAR
#undef PG8_SCHED
}

typedef f32x4 Acc[2][2][4][2];
template <int NV> struct PackT;
template <> struct PackT<2> { typedef u32x4 T; static __device__ __forceinline__ T pack(const f32x4* v) { T w; w.x = pk2(v[0][0], v[0][1]); w.y = pk2(v[0][2], v[0][3]); w.z = pk2(v[1][0], v[1][1]); w.w = pk2(v[1][2], v[1][3]); return w; }
    static __device__ __forceinline__ void unpack(T w, f32x4* v) { v[0] = (f32x4){bflo(w.x), bfhi(w.x), bflo(w.y), bfhi(w.y)}; v[1] = (f32x4){bflo(w.z), bfhi(w.z), bflo(w.w), bfhi(w.w)}; } };
template <> struct PackT<1> { typedef u32x2 T; static __device__ __forceinline__ T pack(const f32x4* v) { T w; w.x = pk2(v[0][0], v[0][1]); w.y = pk2(v[0][2], v[0][3]); return w; }
    static __device__ __forceinline__ void unpack(T w, f32x4* v) { v[0] = (f32x4){bflo(w.x), bfhi(w.x), bflo(w.y), bfhi(w.y)}; } };
template <int NV> __device__ __forceinline__ float sumsq(const f32x4* v) { float s = 0.f;
#pragma unroll
    for (int n = 0; n < NV; ++n) s += (v[n][0] * v[n][0] + v[n][1] * v[n][1]) + (v[n][2] * v[n][2] + v[n][3] * v[n][3]);
    return s; }

template <class T> __device__ __forceinline__ T ldg(const void* base, unsigned byteoff) { return *(const T*)((const char*)base + (size_t)byteoff); }
template <class T> __device__ __forceinline__ void stg(void* base, unsigned byteoff, T v) { *(T*)((char*)base + (size_t)byteoff) = v; }
template <class Epi> struct EpiDrive : Epi {
    static constexpr bool FIN = false;
    __device__ __forceinline__ EpiDrive(const Epi& e) : Epi(e) {}
    __device__ __forceinline__ void tile(const Acc& acc, const Unit& u, int wr, int wc, int fr, int fq) const {
        const int row0 = u.pm * BM + wr * 64 + fr, cseg = wc * 32 + 8 * fq; const bool smp = u.pm >= MP / BM;
        float rsv[2][4];
        if (Epi::RSTD) {
#pragma unroll
            for (int ai = 0; ai < 2; ++ai)
#pragma unroll
                for (int m = 0; m < 4; ++m) rsv[ai][m] = ldg<float>(this->ssq_in, (unsigned)(row0 + ai * HALF + m * 16) * 4u); }
        if constexpr (Epi::PRE > 0) {
#pragma unroll
            for (int ai = 0; ai < 2; ++ai)
#pragma unroll
              for (int mb = 0; mb < 4; mb += Epi::PB) { f32x4 buf[Epi::PB][Epi::PRE];
#pragma unroll
                for (int m = 0; m < Epi::PB; ++m) this->template pre<2>(row0 + ai * HALF + (mb + m) * 16, cseg, u.pn, smp, buf[m]);
#pragma unroll
                for (int m = 0; m < Epi::PB; ++m) { const float rs = Epi::RSTD ? __builtin_amdgcn_rsqf(rsv[ai][mb + m] * (1.f / D) + EPS) : 1.f;
                    this->template seg<2>(row0 + ai * HALF + (mb + m) * 16, cseg, u.pn, acc[ai][0][mb + m], acc[ai][1][mb + m], rs, smp, buf[m]); } }
        } else {
#pragma unroll
            for (int ai = 0; ai < 2; ++ai)
#pragma unroll
                for (int m = 0; m < 4; ++m) { const float rs = Epi::RSTD ? __builtin_amdgcn_rsqf(rsv[ai][m] * (1.f / D) + EPS) : 1.f;
                    this->template seg<2>(row0 + ai * HALF + m * 16, cseg, u.pn, acc[ai][0][m], acc[ai][1][m], rs, smp, nullptr); }
        }
    }
    __device__ __forceinline__ void strip(const f32x4 (&accx)[2], const Unit& u, int wr, int wc, int fr, int fq) const {
        const int row = MP + 16 * u.pm + fr, cseg = wc * 32 + 8 * fq + 4 * wr;
        const float rs = Epi::RSTD ? __builtin_amdgcn_rsqf(ldg<float>(this->ssq_in, (unsigned)row * 4u) * (1.f / D) + EPS) : 1.f;
        if constexpr (Epi::PRE > 0) { f32x4 buf[Epi::PRE]; this->template pre<1>(row, cseg, u.pn, true, buf); this->template seg<1>(row, cseg, u.pn, &accx[0], &accx[1], rs, true, buf); }
        else this->template seg<1>(row, cseg, u.pn, &accx[0], &accx[1], rs, true, nullptr);
    }
};

struct EpiBf16 {
    static constexpr bool RSTD = false; static constexpr int PRE = 0, PB = 1;
    bf16* O; const float* ssq_in;
    template <int NV> __device__ __forceinline__ void seg(int row, int cseg, int pn, const f32x4* v0, const f32x4* v1, float, bool, const f32x4*) const {
        const unsigned ob = (unsigned)(row * D + pn * BM + cseg) * 2u;
        stg(O, ob, PackT<NV>::pack(v0)); stg(O, ob + HALF * 2, PackT<NV>::pack(v1));
    }
};

struct EpiRes {
    static constexpr bool RSTD = false; static constexpr int PRE = 4, PB = 4;
    const float* xinP; const float* xinS; const bf16* xbin;
    bf16* xb; float* ssq_out; const float* colscale; const float* ssq_in;
    template <int NV> __device__ __forceinline__ void pre(int row, int cseg, int pn, bool smp, f32x4* buf) const {
        const unsigned oe = (unsigned)(row * D + pn * BM + cseg);
        if (xbin) {
#pragma unroll
            for (int bj = 0; bj < 2; ++bj) {
                if (NV == 2) buf[bj] = __builtin_bit_cast(f32x4, ldg<u32x4>(xbin, (oe + bj * HALF) * 2u));
                else { const u32x2 e2 = ldg<u32x2>(xbin, (oe + bj * HALF) * 2u); buf[bj] = __builtin_bit_cast(f32x4, (u32x4){e2.x, e2.y, 0u, 0u}); } }
        } else {
            const float* xin = smp ? xinS - (size_t)MP * D : xinP;
#pragma unroll
            for (int bj = 0; bj < 2; ++bj)
#pragma unroll
                for (int n = 0; n < NV; ++n) buf[bj * 2 + n] = ldg<f32x4>(xin, (oe + bj * HALF + 4 * n) * 4u);
        }
    }
    template <int NV> __device__ __forceinline__ void seg(int row, int cseg, int pn, const f32x4* v0, const f32x4* v1, float, bool, const f32x4* buf) const {
        const unsigned oe = (unsigned)(row * D + pn * BM + cseg);
        float ss = 0.f;
#pragma unroll
        for (int bj = 0; bj < 2; ++bj) { const f32x4* v = bj ? v1 : v0; f32x4 r[NV], x[2];
            if (xbin) { const u32x4 w = __builtin_bit_cast(u32x4, buf[bj]); x[0] = (f32x4){bflo(w.x), bfhi(w.x), bflo(w.y), bfhi(w.y)}; x[1] = (f32x4){bflo(w.z), bfhi(w.z), bflo(w.w), bfhi(w.w)}; }
            else { x[0] = buf[bj * 2]; x[1] = buf[bj * 2 + 1]; }
#pragma unroll
            for (int n = 0; n < NV; ++n) { f32x4 a = v[n]; if (colscale) a = a * ldg<f32x4>(colscale, (unsigned)(pn * BM + cseg + bj * HALF + 4 * n) * 4u);
                r[n] = x[n] + a; }
            stg(xb, (oe + bj * HALF) * 2u, PackT<NV>::pack(r)); ss += sumsq<NV>(r); }
        ss += __shfl_xor(ss, 16); ss += __shfl_xor(ss, 32);
        if ((__builtin_amdgcn_mbcnt_hi(~0u, __builtin_amdgcn_mbcnt_lo(~0u, 0u)) >> 4) == 0u) unsafeAtomicAdd(ssq_out + row, ss);
    }
};

struct EpiUp {
    static constexpr bool RSTD = true; static constexpr int PRE = 0, PB = 1;
    bf16* U; const float* ssq_in; float* convP; float* convS;
    template <int NV> __device__ __forceinline__ void seg(int row, int cseg, int pn, const f32x4* v0, const f32x4* v1, float rs, bool smp, const f32x4*) const {
        float* cbase = smp ? convS : convP;
        int crow = -1;
        if (!smp) { const int t = row & (SEQ - 1); if (t >= SEQ - 2) crow = (row >> 11) * 2 + (t - (SEQ - 2)); }
        else { const int s_ = row - MP, t = s_ & 3; if (t >= 2) crow = (s_ >> 2) * 2 + (t - 2); }
        const unsigned ub = (unsigned)(row * F2 + pn * BM + cseg) * 2u;
#pragma unroll
        for (int bj = 0; bj < 2; ++bj) { const f32x4* v = bj ? v1 : v0; f32x4 r[NV];
#pragma unroll
            for (int n = 0; n < NV; ++n) r[n] = v[n] * rs;
            stg(U, ub + bj * HALF * 2, PackT<NV>::pack(r));
            if (crow >= 0) {
#pragma unroll
                for (int n = 0; n < NV; ++n) stg(cbase, (unsigned)(crow * F2 + bj * FF + pn * HALF + cseg + 4 * n) * 4u, r[n]); } }
    }
};

struct EpiPle {
    static constexpr bool RSTD = true; static constexpr int PRE = 4, PB = 4;
    const bf16* xbin; const bf16* emb; const float* ssq_in; bf16* xb; float* ssq_out;
    template <int NV> __device__ __forceinline__ void pre(int row, int cseg, int pn, bool, f32x4* buf) const {
        const unsigned oe = (unsigned)(row * D + pn * BM + cseg);
#pragma unroll
        for (int bj = 0; bj < 2; ++bj) {
            if (NV == 2) { buf[bj] = __builtin_bit_cast(f32x4, ldg<u32x4>(xbin, (oe + bj * HALF) * 2u)); buf[2 + bj] = __builtin_bit_cast(f32x4, ldg<u32x4>(emb, (oe + bj * HALF) * 2u)); }
            else { const u32x2 x2 = ldg<u32x2>(xbin, (oe + bj * HALF) * 2u), e2 = ldg<u32x2>(emb, (oe + bj * HALF) * 2u);
                buf[bj] = __builtin_bit_cast(f32x4, (u32x4){x2.x, x2.y, 0u, 0u}); buf[2 + bj] = __builtin_bit_cast(f32x4, (u32x4){e2.x, e2.y, 0u, 0u}); } }
    }
    template <int NV> __device__ __forceinline__ void seg(int row, int cseg, int pn, const f32x4* v0, const f32x4* v1, float rs, bool, const f32x4* buf) const {
        const unsigned oe = (unsigned)(row * D + pn * BM + cseg);
        float ss = 0.f;
#pragma unroll
        for (int bj = 0; bj < 2; ++bj) { const f32x4* v = bj ? v1 : v0; f32x4 r[NV], e[2], x[2];
            const u32x4 xw = __builtin_bit_cast(u32x4, buf[bj]), ew = __builtin_bit_cast(u32x4, buf[2 + bj]);
            x[0] = (f32x4){bflo(xw.x), bfhi(xw.x), bflo(xw.y), bfhi(xw.y)}; x[1] = (f32x4){bflo(xw.z), bfhi(xw.z), bflo(xw.w), bfhi(xw.w)};
            e[0] = (f32x4){bflo(ew.x), bfhi(ew.x), bflo(ew.y), bfhi(ew.y)}; e[1] = (f32x4){bflo(ew.z), bfhi(ew.z), bflo(ew.w), bfhi(ew.w)};
#pragma unroll
            for (int n = 0; n < NV; ++n) { const f32x4 a = v[n] * rs;
#pragma unroll
                for (int k = 0; k < 4; ++k) r[n][k] = x[n][k] + sigmoid_f(a[k]) * e[n][k]; }
            stg(xb, (oe + bj * HALF) * 2u, PackT<NV>::pack(r)); ss += sumsq<NV>(r); }
        ss += __shfl_xor(ss, 16); ss += __shfl_xor(ss, 32);
        if ((__builtin_amdgcn_mbcnt_hi(~0u, __builtin_amdgcn_mbcnt_lo(~0u, 0u)) >> 4) == 0u) unsafeAtomicAdd(ssq_out + row, ss);
    }
};

struct EpiPleFin {
    static constexpr bool FIN = true;
    const bf16* xin; const bf16* emb; const float* ssq_in; float* ssq_out; const float* gfin; float* out; unsigned* pcnt; unsigned* tmo;
    template <int NV> __device__ __forceinline__ float row(int row, int cseg, int pn, f32x4* v0, f32x4* v1, float rs) const {
        const unsigned oe = (unsigned)(row * D + pn * BM + cseg);
        f32x4 xb_[2][NV]; typename PackT<NV>::T eb[2], xw[2];
#pragma unroll
        for (int bj = 0; bj < 2; ++bj) { eb[bj] = ldg<typename PackT<NV>::T>(emb, (oe + bj * HALF) * 2u); xw[bj] = ldg<typename PackT<NV>::T>(xin, (oe + bj * HALF) * 2u); }
#pragma unroll
        for (int bj = 0; bj < 2; ++bj) PackT<NV>::unpack(xw[bj], xb_[bj]);
        float ss = 0.f;
#pragma unroll
        for (int bj = 0; bj < 2; ++bj) { f32x4* v = bj ? v1 : v0; f32x4 e[NV]; PackT<NV>::unpack(eb[bj], e);
#pragma unroll
            for (int n = 0; n < NV; ++n) { const f32x4 a = v[n] * rs; f32x4 r;
#pragma unroll
                for (int k = 0; k < 4; ++k) r[k] = xb_[bj][n][k] + sigmoid_f(a[k]) * e[n][k];
                v[n] = r; ss += (r[0] * r[0] + r[1] * r[1]) + (r[2] * r[2] + r[3] * r[3]); } }
        ss += __shfl_xor(ss, 16); ss += __shfl_xor(ss, 32);
        return ss;
    }
    __device__ __forceinline__ void tile(Acc& acc, const Unit& u, int wr, int wc, int fr, int fq) const {
        const int row0 = u.pm * BM + wr * 64 + fr, cseg = wc * 32 + 8 * fq;
        float rsv[2][4];
#pragma unroll
        for (int ai = 0; ai < 2; ++ai)
#pragma unroll
            for (int m = 0; m < 4; ++m) rsv[ai][m] = ldg<float>(ssq_in, (unsigned)(row0 + ai * HALF + m * 16) * 4u);
#pragma unroll
        for (int ai = 0; ai < 2; ++ai)
#pragma unroll
            for (int m = 0; m < 4; ++m) { const int r_ = row0 + ai * HALF + m * 16;
                const float ss = row<2>(r_, cseg, u.pn, acc[ai][0][m], acc[ai][1][m], __builtin_amdgcn_rsqf(rsv[ai][m] * (1.f / D) + EPS));
                if (fq == 0) unsafeAtomicAdd(ssq_out + r_, ss); }
    }
    __device__ __forceinline__ void strip(f32x4 (&accx)[2], const Unit& u, int wr, int wc, int fr, int fq) const {
        const int r_ = MP + 16 * u.pm + fr, cseg = wc * 32 + 8 * fq + 4 * wr;
        const float ss = row<1>(r_, cseg, u.pn, &accx[0], &accx[1], __builtin_amdgcn_rsqf(ldg<float>(ssq_in, (unsigned)r_ * 4u) * (1.f / D) + EPS));
        if (fq == 0) unsafeAtomicAdd(ssq_out + r_, ss);
    }
    __device__ __forceinline__ void finish(Acc& acc, f32x4 (&accx)[2], const Unit& u, int wr, int wc, int fr, int fq, int wid) const {
        asm volatile("s_waitcnt vmcnt(0)\n\ts_barrier" ::: "memory");
        if (wid == 0 && fr == 0 && fq == 0) {
            unsigned* c = pcnt + 64 * u.pm;
            __hip_atomic_fetch_add(c, 1u, __ATOMIC_RELAXED, __HIP_MEMORY_SCOPE_AGENT);
            unsigned sp = 0u;
            while (__hip_atomic_load(c, __ATOMIC_RELAXED, __HIP_MEMORY_SCOPE_AGENT) < 8u) { __builtin_amdgcn_s_sleep(1);
                if (++sp > (1u << 22)) { __hip_atomic_store(tmo, 0x900u | (unsigned)u.pm, __ATOMIC_RELAXED, __HIP_MEMORY_SCOPE_AGENT); break; } }
        }
        asm volatile("s_waitcnt vmcnt(0) lgkmcnt(0)\n\ts_barrier" ::: "memory");
        const int row0 = u.pm * BM + wr * 64 + fr, cseg = wc * 32 + 8 * fq;
        float sq[2][4];
#pragma unroll
        for (int ai = 0; ai < 2; ++ai)
#pragma unroll
            for (int m = 0; m < 4; ++m) sq[ai][m] = __builtin_bit_cast(float, __hip_atomic_load((const unsigned*)(ssq_out + row0 + ai * HALF + m * 16), __ATOMIC_RELAXED, __HIP_MEMORY_SCOPE_AGENT));
        const int rx = MP + 16 * u.pm + fr;
        const float sqx = __builtin_bit_cast(float, __hip_atomic_load((const unsigned*)(ssq_out + rx), __ATOMIC_RELAXED, __HIP_MEMORY_SCOPE_AGENT));
        f32x4 g4[2][2];
#pragma unroll
        for (int bj = 0; bj < 2; ++bj)
#pragma unroll
            for (int n = 0; n < 2; ++n) g4[bj][n] = ldg<f32x4>(gfin, (unsigned)(u.pn * BM + bj * HALF + cseg + 4 * n) * 4u);
#pragma unroll
        for (int ai = 0; ai < 2; ++ai)
#pragma unroll
            for (int m = 0; m < 4; ++m) { const float rs = __builtin_amdgcn_rsqf(sq[ai][m] * (1.f / D) + EPS); const unsigned oe = (unsigned)((row0 + ai * HALF + m * 16) * D + u.pn * BM + cseg);
#pragma unroll
                for (int bj = 0; bj < 2; ++bj)
#pragma unroll
                    for (int n = 0; n < 2; ++n) stg(out, (oe + bj * HALF + 4 * n) * 4u, acc[ai][bj][m][n] * rs * g4[bj][n]); }
        { const float rs = __builtin_amdgcn_rsqf(sqx * (1.f / D) + EPS); const unsigned oe = (unsigned)(rx * D + u.pn * BM + cseg + 4 * wr);
#pragma unroll
          for (int bj = 0; bj < 2; ++bj) stg(out, (oe + bj * HALF) * 4u, accx[bj] * rs * g4[bj][wr]); }
    }
};

struct EpiRetIn {
    static constexpr bool RSTD = true; static constexpr int PRE = 0, PB = 1;
    bf16* P; const float* ssq_in; const float* rope;
    template <int NV> __device__ __forceinline__ void seg(int row, int cseg, int pn, const f32x4* v0, const f32x4* v1, float rs, bool smp, const f32x4*) const {
        const int kind = pn < 8 ? 0 : (pn < 16 ? 1 : (pn < 32 ? 2 : 3));
        const unsigned pb = (unsigned)(row * NPROJ + pn * BM + cseg) * 2u;
        f32x4 o1[NV], o2[NV];
        if (kind <= 1) {
            const int pi = smp ? SEQ + ((row - MP) & 3) : (row & (SEQ - 1));
            float sc = rs;
            if (kind == 1) sc *= 0.0625f * (smp ? 1.f : __builtin_amdgcn_exp2f(-(float)((row & 127) + 1) * gamma_l2(pn - 8)));
#pragma unroll
            for (int n = 0; n < NV; ++n) { const f32x4 c = ldg<f32x4>(rope, (unsigned)(pi * 128 + cseg + 4 * n) * 4u), s_ = ldg<f32x4>(rope, (unsigned)((NPOS + pi) * 128 + cseg + 4 * n) * 4u);
                const f32x4 x1 = v0[n] * sc, x2 = v1[n] * sc;
                o1[n] = x1 * c - x2 * s_; o2[n] = x1 * s_ + x2 * c; }
        } else {
#pragma unroll
            for (int n = 0; n < NV; ++n) { o1[n] = v0[n] * rs; o2[n] = v1[n] * rs;
                if (kind == 3) {
#pragma unroll
                    for (int k = 0; k < 4; ++k) { o1[n][k] = silu_f(o1[n][k]); o2[n][k] = silu_f(o2[n][k]); } } }
        }
        stg(P, pb, PackT<NV>::pack(o1)); stg(P, pb + HALF * 2, PackT<NV>::pack(o2));
    }
};

#ifndef ROT_DPP
#define ROT_DPP 1
#endif
#if ROT_DPP
__device__ __forceinline__ float rot1(float x, int) { return __int_as_float(__builtin_amdgcn_update_dpp(0, __float_as_int(x), 0x121  , 0xf, 0xf, false)); }
#else
__device__ __forceinline__ float rot1(float x, int addr) { return __int_as_float(__builtin_amdgcn_ds_bpermute(addr, __float_as_int(x))); }
#endif
__device__ __forceinline__ f32x4 rot4(f32x4 v, int addr) { f32x4 r; r.x = rot1(v.x, addr); r.y = rot1(v.y, addr); r.z = rot1(v.z, addr); r.w = rot1(v.w, addr); return r; }
__device__ __forceinline__ f32x4 sel4(bool c, f32x4 a, f32x4 b) { return (f32x4){c ? a[0] : b[0], c ? a[1] : b[1], c ? a[2] : b[2], c ? a[3] : b[3]}; }
struct EpiUpAct {
    static constexpr bool FIN = false;
    bf16* ACT; const float* ssq_in; float* convP; float* convS; const float* cw; const float* cb; const float* sconv; float* ubnd; LAS float* xch;
    __device__ __forceinline__ void tile(Acc& acc, const Unit& u, int wr, int wc, int fr, int fq) const {
        const int row0 = u.pm * BM + wr * 64 + fr, cseg = wc * 32 + 8 * fq; const bool smp = u.pm >= MP / BM;
        { float rsv[2][4];
#pragma unroll
          for (int ai = 0; ai < 2; ++ai)
#pragma unroll
            for (int m = 0; m < 4; ++m) rsv[ai][m] = ldg<float>(ssq_in, (unsigned)(row0 + ai * HALF + m * 16) * 4u);
#pragma unroll
          for (int ai = 0; ai < 2; ++ai)
#pragma unroll
            for (int m = 0; m < 4; ++m) { const float rs = __builtin_amdgcn_rsqf(rsv[ai][m] * (1.f / D) + EPS);
#pragma unroll
                for (int bj = 0; bj < 2; ++bj)
#pragma unroll
                    for (int n = 0; n < 2; ++n) acc[ai][bj][m][n] = acc[ai][bj][m][n] * rs; } }
        { float* cbase = smp ? convS : convP;
#pragma unroll
          for (int ai = 0; ai < 2; ++ai)
#pragma unroll
            for (int m = 0; m < 4; ++m) { const int row = row0 + ai * HALF + m * 16; int crow = -1;
                if (!smp) { const int t = row & (SEQ - 1); if (t >= SEQ - 2) crow = (row >> 11) * 2 + (t - (SEQ - 2)); }
                else { const int s_ = row - MP, t = s_ & 3; if (t >= 2) crow = (s_ >> 2) * 2 + (t - 2); }
                if (crow >= 0) {
#pragma unroll
                    for (int bj = 0; bj < 2; ++bj)
#pragma unroll
                        for (int n = 0; n < 2; ++n) stg(cbase, (unsigned)(crow * F2 + bj * FF + u.pn * HALF + cseg + 4 * n) * 4u, acc[ai][bj][m][n]); } } }
        if (fr >= 14) {
#pragma unroll
            for (int ai = 0; ai < 2; ++ai)
#pragma unroll
                for (int bj = 0; bj < 2; ++bj)
#pragma unroll
                    for (int n = 0; n < 2; ++n) *(LAS f32x4*)(xch + ((ai * 2 + wr) * 2 + (fr - 14)) * 256 + bj * HALF + cseg + 4 * n) = acc[ai][bj][3][n]; }
        if (!smp) {
            if (wr == 0 && fr < 2) {
#pragma unroll
                for (int bj = 0; bj < 2; ++bj)
#pragma unroll
                    for (int n = 0; n < 2; ++n) stg(ubnd, (unsigned)((u.pm * 4 + fr) * F2 + u.pn * BM + bj * HALF + cseg + 4 * n) * 4u, acc[0][bj][0][n]); }
            if (wr == 1 && fr >= 14) {
#pragma unroll
                for (int bj = 0; bj < 2; ++bj)
#pragma unroll
                    for (int n = 0; n < 2; ++n) stg(ubnd, (unsigned)((u.pm * 4 + 2 + (fr - 14)) * F2 + u.pn * BM + bj * HALF + cseg + 4 * n) * 4u, acc[1][bj][3][n]); }
        }
        asm volatile("s_waitcnt lgkmcnt(0)\n\ts_barrier" ::: "memory");
        const int lane = fq * 16 + fr, baddr = ((lane & 48) | ((fr - 1) & 15)) * 4;
        const bool f1 = fr >= 1, t1 = (fr & 3) >= 1;
#pragma unroll
        for (int n = 0; n < 2; ++n) {
            const int f4 = u.pn * HALF + cseg + 4 * n;
            f32x4 wg[3], wu[3];
#pragma unroll
            for (int j = 0; j < 3; ++j) { wg[j] = ldg<f32x4>(cw, (unsigned)(j * F2 + f4) * 4u); wu[j] = ldg<f32x4>(cw, (unsigned)(j * F2 + FF + f4) * 4u); }
            const f32x4 bg = ldg<f32x4>(cb, (unsigned)f4 * 4u), bu = ldg<f32x4>(cb, (unsigned)(FF + f4) * 4u);
            f32x4 rgp = (f32x4){0.f, 0.f, 0.f, 0.f}, rup = rgp, r1gp = rgp, r1up = rgp;
#pragma unroll
            for (int ai = 0; ai < 2; ++ai)
#pragma unroll
                for (int m = 0; m < 4; ++m) {
                    const int row = row0 + ai * HALF + m * 16;
                    const f32x4 cg = acc[ai][0][m][n], cu = acc[ai][1][m][n];
                    const f32x4 rg = rot4(cg, baddr), ru = rot4(cu, baddr);
                    f32x4 p1g, p1u, p2g, p2u;
                    if (!smp) {
                        if (m == 0) {
                            f32x4 x0g = (f32x4){0.f, 0.f, 0.f, 0.f}, x1g = x0g, x0u = x0g, x1u = x0g;
                            const int bi = ai * 2 + wr;
                            if (bi > 0) { const LAS float* xp = xch + ((bi - 1) * 2) * 256 + cseg + 4 * n;
                                x0g = *(const LAS f32x4*)xp; x1g = *(const LAS f32x4*)(xp + 256); x0u = *(const LAS f32x4*)(xp + HALF); x1u = *(const LAS f32x4*)(xp + 256 + HALF); }
                            p1g = sel4(f1, rg, x1g); p1u = sel4(f1, ru, x1u);
                            const f32x4 r1g = rot4(p1g, baddr), r1u = rot4(p1u, baddr);
                            p2g = sel4(f1, r1g, x0g); p2u = sel4(f1, r1u, x0u); r1gp = r1g; r1up = r1u;
                        } else {
                            p1g = sel4(f1, rg, rgp); p1u = sel4(f1, ru, rup);
                            const f32x4 r1g = rot4(p1g, baddr), r1u = rot4(p1u, baddr);
                            p2g = sel4(f1, r1g, r1gp); p2u = sel4(f1, r1u, r1up); r1gp = r1g; r1up = r1u;
                        }
                    } else {
                        const unsigned so = (unsigned)(((row - MP) >> 2) * 2 * F2 + f4) * 4u;
                        const f32x4 s0g = ldg<f32x4>(sconv, so), s1g = ldg<f32x4>(sconv, so + F2 * 4u), s0u = ldg<f32x4>(sconv, so + FF * 4u), s1u = ldg<f32x4>(sconv, so + (F2 + FF) * 4u);
                        p1g = sel4(t1, rg, s1g); p1u = sel4(t1, ru, s1u);
                        const f32x4 r1g = rot4(p1g, baddr), r1u = rot4(p1u, baddr);
                        p2g = sel4(t1, r1g, s0g); p2u = sel4(t1, r1u, s0u);
                    }
                    rgp = rg; rup = ru;
                    const f32x4 gg = wg[0] * p2g + wg[1] * p1g + wg[2] * cg + bg, uu = wu[0] * p2u + wu[1] * p1u + wu[2] * cu + bu;
                    u32x2 w; w.x = pk2(silu_f(gg[0]) * uu[0], silu_f(gg[1]) * uu[1]); w.y = pk2(silu_f(gg[2]) * uu[2], silu_f(gg[3]) * uu[3]);
                    stg(ACT, (unsigned)(row * FF + f4) * 2u, w);
                }
        }
    }
    __device__ __forceinline__ void strip(const f32x4 (&)[2], const Unit&, int, int, int, int) const {}
};
}

#define XB_TMO      128
#define XB_XCNT(j)  (256  + 64 * (j))
#define XB_XSUB(j)  (1280 + 64 * (j))
#define XB_XGEN(j)  (2304 + 64 * (j))
#define XB_TOP      3328
#define XB_TOPGEN   3392
#define XCD_BAR_WORDS 3456
#define XB_SPIN_CAP (1u << 22)
__device__ __forceinline__ unsigned xb_ld(unsigned* p)              { return __hip_atomic_load(p, __ATOMIC_RELAXED, __HIP_MEMORY_SCOPE_AGENT); }
__device__ __forceinline__ unsigned xb_add(unsigned* p, unsigned v) { return __hip_atomic_fetch_add(p, v, __ATOMIC_RELAXED, __HIP_MEMORY_SCOPE_AGENT); }
__device__ __forceinline__ unsigned xb_xcc_id() { return (unsigned)__builtin_amdgcn_s_getreg((3 << 11) | 20) & 0xFu; }
#define XB_SPIN(cond, bar) do { unsigned _sp = 0; while (cond) { __builtin_amdgcn_s_sleep(1); \
    if ((++_sp & 255u) == 0u) { if (xb_ld(&(bar)[XB_TMO])) break; if (_sp > XB_SPIN_CAP) { atomicAdd(&(bar)[XB_TMO], 1u); break; } } } } while (0)
struct XcdBarrier { unsigned* bar; unsigned x; volatile LAS unsigned* st; };
__device__ __forceinline__ XcdBarrier xcd_barrier_post(unsigned* bar, volatile LAS unsigned* st) {
    XcdBarrier b; b.bar = bar; b.x = xb_xcc_id(); b.st = st;
    if (threadIdx.x == 0) (void)xb_add(&bar[XB_XCNT(b.x)], 1u);
    return b;
}
__device__ __forceinline__ void xcd_barrier_complete(unsigned* bar, unsigned x, unsigned& nloc, unsigned& nx) {
    const unsigned G = gridDim.x * gridDim.y * gridDim.z;
    unsigned sum, cnt, mine, sp = 0u;
    for (;;) {
        sum = 0u; cnt = 0u; mine = 0u;
#pragma unroll
        for (unsigned j = 0; j < 16; ++j) { const unsigned c = xb_ld(&bar[XB_XCNT(j)]); sum += c; cnt += (c > 0u) ? 1u : 0u; mine = (j == x) ? c : mine; }
        if (sum == G) break;
        __builtin_amdgcn_s_sleep(1);
        if ((++sp & 255u) == 0u) { if (xb_ld(&bar[XB_TMO])) break; if (sp > XB_SPIN_CAP) { atomicAdd(&bar[XB_TMO], 1u); break; } }
    }
    nloc = mine > 0u ? mine : 1u; nx = cnt > 0u ? cnt : 1u;
}
__device__ __forceinline__ void xcd_barrier(const XcdBarrier& b, int wave_s) {
    asm volatile("s_waitcnt vmcnt(0)" ::: "memory");
    __syncthreads();
    if (wave_s == 0 && __builtin_amdgcn_mbcnt_hi(~0u, __builtin_amdgcn_mbcnt_lo(~0u, 0u)) == 0u) {
        unsigned* bar = b.bar;
        __builtin_amdgcn_s_waitcnt(0);
        unsigned nloc = b.st[0], nx = b.st[1];
        if (nloc == 0u) { xcd_barrier_complete(bar, b.x, nloc, nx); b.st[0] = nloc; b.st[1] = nx; }
        const unsigned old = xb_add(&bar[XB_XSUB(b.x)], 1u);
        const unsigned gen = old / nloc;
        if (old + 1u == (gen + 1u) * nloc) {
            __builtin_amdgcn_fence(__ATOMIC_RELEASE, "agent");
            asm volatile("s_waitcnt vmcnt(0)" ::: "memory");
            const unsigned og = xb_add(&bar[XB_TOP], 1u);
            const unsigned tg = og / nx;
            if (og + 1u == (tg + 1u) * nx) xb_add(&bar[XB_TOPGEN], 1u);
            else XB_SPIN(xb_ld(&bar[XB_TOPGEN]) == tg, bar);
            __builtin_amdgcn_fence(__ATOMIC_ACQUIRE, "agent");
            xb_add(&bar[XB_XGEN(b.x)], 1u);
            asm volatile("s_waitcnt vmcnt(0)" ::: "memory");
        } else {
            XB_SPIN(xb_ld(&bar[XB_XGEN(b.x)]) == gen, bar);
            __builtin_amdgcn_fence(__ATOMIC_ACQUIRE, "agent");
            asm volatile("s_waitcnt vmcnt(0)" ::: "memory");
        }
    }
    __syncthreads();
}

struct Args { const float* in[21]; float* out; unsigned char* ws; int ph_lo, ph_hi; };
static_assert(sizeof(Args) == 21 * 8 + 8 + 8 + 8, "Args has no padding");

struct TItem { const float* W; bf16* WT; const float* gain; int K, N, row_off, mode, item; };
__device__ __forceinline__ void p0_tr_load(const TItem& t, f32x4 (&v)[8], float (&gv)[8], int lane) {
    const int nblk = t.N / 32, kb = t.item / nblk, nb = t.item % nblk, k0 = 64 * kb, n0 = 32 * nb, kr = lane >> 3, nq = lane & 7;
#pragma unroll
    for (int i = 0; i < 8; ++i) v[i] = __builtin_nontemporal_load((const f32x4*)(t.W + (size_t)(k0 + 8 * i + kr) * t.N + n0 + 4 * nq));
#pragma unroll
    for (int i = 0; i < 8; ++i) gv[i] = t.gain ? t.gain[k0 + 8 * i + kr] : 1.f;
}
__device__ __forceinline__ void p0_tr_store(const TItem& t, const f32x4 (&v)[8], const float (&gv)[8], LAS float* scr, int lane) {
    const int nblk = t.N / 32, kb = t.item / nblk, nb = t.item % nblk, k0 = 64 * kb, n0 = 32 * nb, kr = lane >> 3, nq = lane & 7;
#pragma unroll
    for (int i = 0; i < 8; ++i) { const int kk = 8 * i + kr; const f32x4 w = v[i] * gv[i];
        LAS float* d = scr + kk * 33 + 4 * nq; d[0] = w[0]; d[1] = w[1]; d[2] = w[2]; d[3] = w[3]; }
    asm volatile("s_waitcnt lgkmcnt(0)" ::: "memory");
    int drow0 = t.row_off + n0;
    if (t.mode == 1) drow0 = (n0 < FF) ? 256 * (n0 >> 7) + (n0 & 127) : 256 * ((n0 - FF) >> 7) + 128 + ((n0 - FF) & 127);
    const int c = lane & 7;
#pragma unroll
    for (int j = 0; j < 4; ++j) { const int n = (lane >> 3) + 8 * j; const LAS float* s_ = scr + (8 * c) * 33 + n;
        u32x4 o; o.x = pk2(s_[0 * 33], s_[1 * 33]); o.y = pk2(s_[2 * 33], s_[3 * 33]); o.z = pk2(s_[4 * 33], s_[5 * 33]); o.w = pk2(s_[6 * 33], s_[7 * 33]);
        *(u32x4*)(t.WT + (size_t)(drow0 + n) * t.K + k0 + 8 * c) = o; }
    asm volatile("s_waitcnt lgkmcnt(0)" ::: "memory");
}

__device__ __forceinline__ void sincos_d(double a, double& s, double& c) {
    const double kq = __builtin_rint(a * 0.63661977236758134308);
    double r = __builtin_fma(-kq, 1.57079632679489655800e+00, a); r = __builtin_fma(-kq, 6.12323399573676603587e-17, r);
    const int q = (int)((long long)kq & 3);
    const double r2 = r * r;
    const double sp = r * (1.0 + r2 * (-1.0 / 6 + r2 * (1.0 / 120 + r2 * (-1.0 / 5040 + r2 * (1.0 / 362880 + r2 * (-1.0 / 39916800 + r2 * (1.0 / 6227020800.0)))))));
    const double cp = 1.0 + r2 * (-0.5 + r2 * (1.0 / 24 + r2 * (-1.0 / 720 + r2 * (1.0 / 40320 + r2 * (-1.0 / 3628800 + r2 * (1.0 / 479001600 + r2 * (-1.0 / 87178291200.0)))))));
    s = (q == 0) ? sp : (q == 1) ? cp : (q == 2) ? -sp : -cp;
    c = (q == 0) ? cp : (q == 1) ? -sp : (q == 2) ? -cp : sp;
}

__device__ __forceinline__ void p0_pool_item(const Args& a, LAS unsigned char* lds, int item, int tid, int wave, int lane) {
    LAS float* rs = (LAS float*)lds;
    const bool prompt = item < 256;
    const float* xbase; int nrows, nhalo, b, t0;
    if (prompt) { b = item >> 6; t0 = (item & 63) * 32; xbase = a.in[0] + (size_t)b * SEQ * D; nrows = 47; nhalo = 15; }
    else { b = item - 256; t0 = 0; xbase = a.in[1] + (size_t)b * DS * D; nrows = 19; nhalo = 15; }
    for (int e0 = wave; e0 < nrows; e0 += 2 * NWAVES) {
        f32x4 xv[2][8]; float r[2] = {0.f, 0.f};
#pragma unroll
        for (int h = 0; h < 2; ++h) { const int e = e0 + h * NWAVES, t = t0 - nhalo + e;
            if (e < nrows && t >= 0) { const f32x4* xr = (const f32x4*)(xbase + (size_t)t * D) + lane;
#pragma unroll
                for (int j = 0; j < 8; ++j) xv[h][j] = xr[64 * j]; } }
#pragma unroll
        for (int h = 0; h < 2; ++h) { const int e = e0 + h * NWAVES, t = t0 - nhalo + e;
            if (e < nrows) {
                if (t >= 0) { float s_ = 0.f;
#pragma unroll
                    for (int j = 0; j < 8; ++j) { const f32x4 v = xv[h][j]; s_ += (v.x * v.x + v.y * v.y) + (v.z * v.z + v.w * v.w); }
                    r[h] = __builtin_amdgcn_rsqf(wave_sum(s_) * (1.f / D) + EPS); }
                if (lane == 0) rs[e] = r[h]; } }
    }
    __syncthreads();
    const int c0 = 4 * tid, win = 2 << (tid >> 7);
    const f32x4 g4 = *(const f32x4*)(a.in[7] + c0);
    bf16* DPRE = (bf16*)(a.ws + WS_DPRE);
    f32x4 w[16];
#pragma unroll
    for (int j = 0; j < 16; ++j) w[j] = (f32x4){0.f, 0.f, 0.f, 0.f};
    for (int e0 = 0; e0 < nrows; e0 += 8) {
        f32x4 xv[8];
#pragma unroll
        for (int i = 0; i < 8; ++i) { const int e = e0 + i, t = t0 - nhalo + e;
            xv[i] = (f32x4){0.f, 0.f, 0.f, 0.f};
            if (e < nrows) {
                if (prompt) { if (t >= 0) xv[i] = *(const f32x4*)(xbase + (size_t)t * D + c0); }
                else { if (e < 15) xv[i] = *(const f32x4*)(a.in[4] + ((size_t)b * PBUF + e) * D + c0); else xv[i] = *(const f32x4*)(xbase + (size_t)t * D + c0); } } }
#pragma unroll
        for (int i = 0; i < 8; ++i) { const int e = e0 + i, t = t0 - nhalo + e;
            if (e < nrows) {
                f32x4 hv = xv[i];
                if (prompt || e >= 15) hv = hv * rs[e] * g4;
#pragma unroll
                for (int j = 15; j > 0; --j) w[j] = w[j - 1];
                w[0] = hv;
                if (e >= nhalo) {
                    f32x4 s4 = (f32x4){0.f, 0.f, 0.f, 0.f};
#pragma unroll
                    for (int j = 0; j < 16; ++j) if (j < win) s4 += w[j];
                    const int cnt = prompt ? ((t + 1 < win) ? t + 1 : win) : win;
                    const f32x4 d = s4 * (1.f / (float)cnt) - hv;
                    const int row = prompt ? b * SEQ + t : MP + b * DS + t;
                    u32x2 o; o.x = pk2(d[0], d[1]); o.y = pk2(d[2], d[3]);
                    *(u32x2*)(DPRE + (size_t)row * D + c0) = o;
                }
                if (prompt) { if (t >= SEQ - PBUF) *(f32x4*)(a.out + O_PP + ((size_t)b * PBUF + (t - (SEQ - PBUF))) * D + c0) = hv; }
                else { if (e >= 4) *(f32x4*)(a.out + O_PS + ((size_t)b * PBUF + (e - 4)) * D + c0) = hv; }
            } }
    }
    __syncthreads();
}

#define LAUNDER_TID() int wave = __builtin_amdgcn_readfirstlane(wave_s); int lane = (int)__builtin_amdgcn_mbcnt_hi(~0u, __builtin_amdgcn_mbcnt_lo(~0u, 0u)); asm volatile("" : "+v"(lane)); int tid = wave * 64 + lane; (void)tid
__device__ __forceinline__ void p0_prologue(const Args& a, LAS unsigned char* lds, int wave_s) {
    LAUNDER_TID();
    const int G = gridDim.x, gw = blockIdx.x * NWAVES + wave, NGW = G * NWAVES;
    unsigned char* ws = a.ws;
    LAS float* scr = (LAS float*)(lds + wave * 16384);
    constexpr int I_POOL = 8 * 16, I_WP = 4 * 64, I_WG = 32 * 64, I_UP = 32 * 352, I_DN = 88 * 64, I_IN = 32 * 384, I_OUT = 64 * 64;
    constexpr int NITEMS = 4 * I_POOL + 2 * I_WP + 2 * I_WG + 2 * I_UP + 2 * I_DN + I_IN + I_OUT;
    auto decode = [&](int it) -> TItem {
        int r = it;
        if (r < 4 * I_POOL) { const int gI = r / I_POOL; return TItem{a.in[11] + (size_t)gI * 512 * 512, (bf16*)(ws + WS_WPOOL), nullptr, 512, 512, gI * 512, 0, r % I_POOL}; } r -= 4 * I_POOL;
        if (r < 2 * I_WP) { const int l = r / I_WP; return TItem{a.in[19] + (size_t)l * PLE * D, (bf16*)(ws + WS_WP) + (size_t)l * D * PLE, nullptr, PLE, D, 0, 0, r % I_WP}; } r -= 2 * I_WP;
        if (r < 2 * I_WG) { const int l = r / I_WG; return TItem{a.in[20] + (size_t)l * D * D, (bf16*)(ws + WS_WG) + (size_t)l * D * D, a.in[9] + l * D, D, D, 0, 0, r % I_WG}; } r -= 2 * I_WG;
        if (r < 2 * I_UP) { const int l = r / I_UP; return TItem{a.in[15] + (size_t)l * D * F2, (bf16*)(ws + WS_WUP) + (size_t)l * F2 * D, a.in[8] + l * D, D, F2, 0, 1, r % I_UP}; } r -= 2 * I_UP;
        if (r < 2 * I_DN) { const int l = r / I_DN; return TItem{a.in[18] + (size_t)l * FF * D, (bf16*)(ws + WS_WDN) + (size_t)l * D * FF, nullptr, FF, D, 0, 0, r % I_DN}; } r -= 2 * I_DN;
        if (r < I_IN) return TItem{a.in[13], (bf16*)(ws + WS_WIN), a.in[7] + D, D, NPROJ, 0, 0, r}; r -= I_IN;
        return TItem{a.in[14], (bf16*)(ws + WS_WOUT), nullptr, 4096, D, 0, 0, r};
    };
    if (gw < NITEMS) {
        TItem cur = decode(gw); f32x4 v[8]; float gv[8];
        p0_tr_load(cur, v, gv, lane);
        for (int it = gw; it < NITEMS; it += NGW) {
            const bool has = it + NGW < NITEMS;
            TItem nxt = cur; f32x4 vn[8]; float gn[8];
            if (has) { nxt = decode(it + NGW); p0_tr_load(nxt, vn, gn, lane); }
            p0_tr_store(cur, v, gv, scr, lane);
            if (has) { cur = nxt;
#pragma unroll
                for (int i = 0; i < 8; ++i) { v[i] = vn[i]; gv[i] = gn[i]; } }
        }
    }
    const int gt = blockIdx.x * NT + tid, NGT = G * NT;
    for (int i = gt; i < 2 * M * PLE / 8; i += NGT) {
        const int e = i * 8, l = e / (M * PLE), rem = e - l * (M * PLE), m = rem / PLE, c = rem % PLE;
        const float* src = (m < MP) ? a.in[2] + ((size_t)l * MP + m) * PLE + c : a.in[3] + ((size_t)l * MS + (m - MP)) * PLE + c;
        const f32x4 v0 = *(const f32x4*)src, v1 = *(const f32x4*)(src + 4);
        { u32x4 w; w.x = pk2(v0[0], v0[1]); w.y = pk2(v0[2], v0[3]); w.z = pk2(v1[0], v1[1]); w.w = pk2(v1[2], v1[3]); *(u32x4*)((bf16*)(ws + WS_PB) + e) = w; }
    }
    float* rope = (float*)(ws + WS_ROPE);
    for (int i = gt; i < NPOS * 128; i += NGT) {
        const int pi = i >> 7, j = i & 127;
        const double pos = (pi < SEQ) ? (double)pi : (double)(PAST + (pi - SEQ));
        const double inv = exp(-(double)j * (9.210340371976182736 / 128.0));
        double s, c; sincos_d(pos * inv, s, c);
        rope[i] = (float)c; rope[NPOS * 128 + i] = (float)s;
    }
    __syncthreads();
    for (int it = blockIdx.x; it < 256 + DB; it += G) p0_pool_item(a, lds, it, tid, wave, lane);
}

__device__ __forceinline__ void act_phase(const Args& a, int layer, int wave_s) {
    LAUNDER_TID();
    const int G = gridDim.x, gw = blockIdx.x * NWAVES + wave, NGW = G * NWAVES;
    const bf16* U = (const bf16*)(a.ws + WS_U); bf16* ACT = (bf16*)(a.ws + WS_ACT);
    const float* cw = a.in[16] + (size_t)layer * 3 * F2; const float* cb = a.in[17] + (size_t)layer * F2;
    const float* sconv = a.in[6] + (size_t)layer * DB * 2 * F2;
    constexpr int NRR = M / 32, NCB = FF / 512;
    for (int it = gw; it < NRR * NCB; it += NGW) {
        const int rr = it / NCB, cbk = it % NCB, m0 = rr * 32, f0 = cbk * 512 + lane * 8;
        const int ug = 256 * (f0 >> 7) + (f0 & 127), uu = ug + 128;
        float wg[3][8], wu[3][8], bg[8], bu[8];
#pragma unroll
        for (int j = 0; j < 3; ++j)
#pragma unroll
            for (int h = 0; h < 2; ++h) { const f32x4 vg = *(const f32x4*)(cw + (size_t)j * F2 + f0 + 4 * h), vu = *(const f32x4*)(cw + (size_t)j * F2 + FF + f0 + 4 * h);
#pragma unroll
                for (int e = 0; e < 4; ++e) { wg[j][4 * h + e] = vg[e]; wu[j][4 * h + e] = vu[e]; } }
#pragma unroll
        for (int h = 0; h < 2; ++h) { const f32x4 vg = *(const f32x4*)(cb + f0 + 4 * h), vu = *(const f32x4*)(cb + FF + f0 + 4 * h);
#pragma unroll
            for (int e = 0; e < 4; ++e) { bg[4 * h + e] = vg[e]; bu[4 * h + e] = vu[e]; } }
        float p1g[8], p2g[8], p1u[8], p2u[8];
        for (int r = 0; r < 32; ++r) {
            const int m = m0 + r; const bool prompt = m < MP; const int t = prompt ? (m & (SEQ - 1)) : ((m - MP) & 3);
            if (r == 0 || t == 0) {
#pragma unroll
                for (int back = 2; back >= 1; --back) {
                    float tg[8], tu[8]; const int tt = t - back;
                    if (tt >= 0) { const u32x4 vg = *(const u32x4*)(U + (size_t)(m - back) * F2 + ug), vu = *(const u32x4*)(U + (size_t)(m - back) * F2 + uu);
                        tg[0] = bflo(vg.x); tg[1] = bfhi(vg.x); tg[2] = bflo(vg.y); tg[3] = bfhi(vg.y); tg[4] = bflo(vg.z); tg[5] = bfhi(vg.z); tg[6] = bflo(vg.w); tg[7] = bfhi(vg.w);
                        tu[0] = bflo(vu.x); tu[1] = bfhi(vu.x); tu[2] = bflo(vu.y); tu[3] = bfhi(vu.y); tu[4] = bflo(vu.z); tu[5] = bfhi(vu.z); tu[6] = bflo(vu.w); tu[7] = bfhi(vu.w); }
                    else if (prompt) {
#pragma unroll
                        for (int e = 0; e < 8; ++e) { tg[e] = 0.f; tu[e] = 0.f; } }
                    else { const float* sp = sconv + ((size_t)((m - MP) >> 2) * 2 + (2 + tt)) * F2;
#pragma unroll
                        for (int h = 0; h < 2; ++h) { const f32x4 vg = *(const f32x4*)(sp + f0 + 4 * h), vu = *(const f32x4*)(sp + FF + f0 + 4 * h);
#pragma unroll
                            for (int e = 0; e < 4; ++e) { tg[4 * h + e] = vg[e]; tu[4 * h + e] = vu[e]; } } }
#pragma unroll
                    for (int e = 0; e < 8; ++e) { if (back == 2) { p2g[e] = tg[e]; p2u[e] = tu[e]; } else { p1g[e] = tg[e]; p1u[e] = tu[e]; } }
                }
            }
            const u32x4 vg = *(const u32x4*)(U + (size_t)m * F2 + ug), vu = *(const u32x4*)(U + (size_t)m * F2 + uu);
            float cg[8], cu[8];
            cg[0] = bflo(vg.x); cg[1] = bfhi(vg.x); cg[2] = bflo(vg.y); cg[3] = bfhi(vg.y); cg[4] = bflo(vg.z); cg[5] = bfhi(vg.z); cg[6] = bflo(vg.w); cg[7] = bfhi(vg.w);
            cu[0] = bflo(vu.x); cu[1] = bfhi(vu.x); cu[2] = bflo(vu.y); cu[3] = bfhi(vu.y); cu[4] = bflo(vu.z); cu[5] = bfhi(vu.z); cu[6] = bflo(vu.w); cu[7] = bfhi(vu.w);
            float o[8];
#pragma unroll
            for (int e = 0; e < 8; ++e) { const float gg = wg[0][e] * p2g[e] + wg[1][e] * p1g[e] + wg[2][e] * cg[e] + bg[e], up = wu[0][e] * p2u[e] + wu[1][e] * p1u[e] + wu[2][e] * cu[e] + bu[e];
                o[e] = silu_f(gg) * up; p2g[e] = p1g[e]; p1g[e] = cg[e]; p2u[e] = p1u[e]; p1u[e] = cu[e]; }
            u32x4 w; w.x = pk2(o[0], o[1]); w.y = pk2(o[2], o[3]); w.z = pk2(o[4], o[5]); w.w = pk2(o[6], o[7]);
            *(u32x4*)(ACT + (size_t)m * FF + f0) = w;
        }
    }
}

__device__ __forceinline__ bf16x8 cat8(s16x4 a, s16x4 b) { return __builtin_shufflevector(a, b, 0, 1, 2, 3, 4, 5, 6, 7); }
typedef short v4i16_t __attribute__((ext_vector_type(4)));
__device__ __forceinline__ s16x4 vtr(const LAS unsigned char* p) { return __builtin_bit_cast(s16x4, __builtin_amdgcn_ds_read_tr16_b64_v4i16((LAS v4i16_t*)p)); }
#define LBAR() asm volatile("s_waitcnt lgkmcnt(0)\n\ts_barrier" ::: "memory")
constexpr int KN_P = 528, VN_P = 144, ST_P = 528;
constexpr int KN_OFF = 0, VN_OFF = 128 * KN_P, ST_OFF = VN_OFF + 128 * VN_P, RET_LDS_END = ST_OFF + 64 * ST_P;
static_assert(RET_LDS_END <= RING_BYTES, "retention LDS");
static_assert(XCH_OFF + XCH_BYTES <= LDS_BYTES, "LDS map");

__device__ __forceinline__ void ret_prompt_item(const Args& a, LAS unsigned char* lds, int item, int wave_s) {
    LAUNDER_TID();
    const int b = item >> 6, h = (item >> 3) & 7, sl = item & 7, fr = lane & 15, fq = lane >> 4;
    const bf16* PROJ = (const bf16*)(a.ws + WS_PROJ); bf16* OB = (bf16*)(a.ws + WS_OB);
    LAS unsigned char* Kn = lds + KN_OFF; LAS unsigned char* Vn = lds + VN_OFF; LAS unsigned char* St = lds + ST_OFF;
    const float l2g = gamma_l2(h);
    const int qb = (wave < 4) ? wave : 11 - wave;
    const float sdec = __builtin_amdgcn_exp2f(128.f * l2g), cross = __builtin_amdgcn_exp2f((float)(16 * qb + fr + 1) * l2g);
    for (int i = tid; i < 64 * ST_P / 16; i += NT) ((LAS u32x4*)St)[i] = (u32x4){0u, 0u, 0u, 0u};
    f32x4 S[2][4];
#pragma unroll
    for (int x = 0; x < 2; ++x)
#pragma unroll
        for (int y = 0; y < 4; ++y) S[x][y] = (f32x4){0.f, 0.f, 0.f, 0.f};
    u32x4 kst[8], vst[2]; bf16x8 qf[8];
    const char* kbase = (const char*)(PROJ + (size_t)b * SEQ * NPROJ + 2048 + h * DK);
    const char* vbase = (const char*)(PROJ + (size_t)b * SEQ * NPROJ + 4096 + h * DV + sl * 64);
    const char* qbase = (const char*)(PROJ + (size_t)b * SEQ * NPROJ + h * DK);
    char* obase = (char*)(OB + (size_t)b * SEQ * 4096 + h * DV + sl * 64);
    const unsigned klane = (unsigned)((tid >> 5) * NPROJ + (tid & 31) * 8) * 2u, vlane = (unsigned)((tid >> 3) * NPROJ + (tid & 7) * 8) * 2u;
    const unsigned qlane = (unsigned)((16 * qb + fr) * NPROJ + 8 * fq) * 2u, olane = (unsigned)((16 * qb + fr) * 4096 + 4 * fq) * 2u;
    constexpr size_t CH_IN = (size_t)128 * NPROJ * 2, CH_OUT = (size_t)128 * 4096 * 2;
#define RET_LOAD_KV(c) do { const char* kc = kbase + (size_t)(c) * CH_IN; const char* vc = vbase + (size_t)(c) * CH_IN; \
        _Pragma("unroll") for (int i = 0; i < 8; ++i) kst[i] = *(const u32x4*)(kc + (size_t)i * 16 * NPROJ * 2 + klane); \
        _Pragma("unroll") for (int i = 0; i < 2; ++i) vst[i] = *(const u32x4*)(vc + (size_t)i * 64 * NPROJ * 2 + vlane); } while (0)
#define RET_LOAD_Q(c) do { const char* qc = qbase + (size_t)(c) * CH_IN; \
        _Pragma("unroll") for (int kk = 0; kk < 8; ++kk) qf[kk] = *(const bf16x8*)(qc + 64 * kk + qlane); } while (0)
    RET_LOAD_KV(0); RET_LOAD_Q(0);
    LBAR();
    for (int c = 0; c < 16; ++c) {
#pragma unroll
        for (int i = 0; i < 8; ++i) { const int p = tid + NT * i; *(LAS u32x4*)(Kn + (p >> 5) * KN_P + (p & 31) * 16) = kst[i]; }
#pragma unroll
        for (int i = 0; i < 2; ++i) { const int p = tid + NT * i; *(LAS u32x4*)(Vn + (p >> 3) * VN_P + (p & 7) * 16) = vst[i]; }
        LBAR();
        u32x2 pk[8];
#pragma unroll
        for (int jj = 0; jj < 4; ++jj) {
            pk[2 * jj] = (u32x2){0u, 0u}; pk[2 * jj + 1] = (u32x2){0u, 0u};
            if (2 * jj <= qb) {
                f32x4 p0 = (f32x4){0.f, 0.f, 0.f, 0.f}, p1 = (f32x4){0.f, 0.f, 0.f, 0.f};
#pragma unroll
                for (int kk = 0; kk < 8; ++kk) {
                    const bf16x8 X0 = *(const LAS bf16x8*)(Kn + (32 * jj + fr) * KN_P + (32 * kk + 8 * fq) * 2);
                    const bf16x8 X1 = *(const LAS bf16x8*)(Kn + (32 * jj + 16 + fr) * KN_P + (32 * kk + 8 * fq) * 2);
                    p0 = __builtin_amdgcn_mfma_f32_16x16x32_bf16(X0, qf[kk], p0, 0, 0, 0);
                    p1 = __builtin_amdgcn_mfma_f32_16x16x32_bf16(X1, qf[kk], p1, 0, 0, 0); }
                if (2 * jj == qb) {
#pragma unroll
                    for (int i = 0; i < 4; ++i) { if (4 * fq + i > fr) p0[i] = 0.f; p1[i] = 0.f; } }
                else if (2 * jj + 1 == qb) {
#pragma unroll
                    for (int i = 0; i < 4; ++i) if (4 * fq + i > fr) p1[i] = 0.f; }
                pk[2 * jj].x = pk2(p0[0], p0[1]); pk[2 * jj].y = pk2(p0[2], p0[3]); pk[2 * jj + 1].x = pk2(p1[0], p1[1]); pk[2 * jj + 1].y = pk2(p1[2], p1[3]);
            }
        }
        if (c + 1 < 16) RET_LOAD_KV(c + 1);
        f32x4 o[4];
#pragma unroll
        for (int vb = 0; vb < 4; ++vb) { o[vb] = (f32x4){0.f, 0.f, 0.f, 0.f};
#pragma unroll
            for (int kk = 0; kk < 8; ++kk) { const bf16x8 X = *(const LAS bf16x8*)(St + (16 * vb + fr) * ST_P + (32 * kk + 8 * fq) * 2); o[vb] = __builtin_amdgcn_mfma_f32_16x16x32_bf16(X, qf[kk], o[vb], 0, 0, 0); } }
        if (c + 1 < 16) RET_LOAD_Q(c + 1);
#pragma unroll
        for (int jj = 0; jj < 4; ++jj) {
            if (2 * jj <= qb) {
                const u32x4 yw = (u32x4){pk[2 * jj].x, pk[2 * jj].y, pk[2 * jj + 1].x, pk[2 * jj + 1].y};
                const bf16x8 Y = __builtin_bit_cast(bf16x8, yw);
#pragma unroll
                for (int vb = 0; vb < 4; ++vb) {
                    const s16x4 t0 = vtr(Vn + (32 * jj + 4 * fq + (fr >> 2)) * VN_P + (16 * vb + 4 * (fr & 3)) * 2);
                    const s16x4 t1 = vtr(Vn + (32 * jj + 16 + 4 * fq + (fr >> 2)) * VN_P + (16 * vb + 4 * (fr & 3)) * 2);
                    o[vb] = __builtin_amdgcn_mfma_f32_16x16x32_bf16(cat8(t0, t1), Y, o[vb], 0, 0, 0);
                }
            }
        }
        { char* oc = obase + (size_t)c * CH_OUT;
#pragma unroll
            for (int vb = 0; vb < 4; ++vb) { u32x2 w; w.x = pk2(o[vb][0] * cross, o[vb][1] * cross); w.y = pk2(o[vb][2] * cross, o[vb][3] * cross); *(u32x2*)(oc + 32 * vb + olane) = w; } }
        LBAR();
#pragma unroll
        for (int kk = 0; kk < 4; ++kk) {
            bf16x8 Yv[4];
#pragma unroll
            for (int vb = 0; vb < 4; ++vb) {
                const s16x4 t0 = vtr(Vn + (32 * kk + 8 * fq + (fr >> 2)) * VN_P + (16 * vb + 4 * (fr & 3)) * 2);
                const s16x4 t1 = vtr(Vn + (32 * kk + 8 * fq + 4 + (fr >> 2)) * VN_P + (16 * vb + 4 * (fr & 3)) * 2);
                Yv[vb] = cat8(t0, t1); }
#pragma unroll
            for (int kbl = 0; kbl < 2; ++kbl) { const int kb = 2 * wave + kbl;
                const s16x4 t0 = vtr(Kn + (32 * kk + 8 * fq + (fr >> 2)) * KN_P + (16 * kb + 4 * (fr & 3)) * 2);
                const s16x4 t1 = vtr(Kn + (32 * kk + 8 * fq + 4 + (fr >> 2)) * KN_P + (16 * kb + 4 * (fr & 3)) * 2);
                const bf16x8 X = cat8(t0, t1);
#pragma unroll
                for (int vb = 0; vb < 4; ++vb) S[kbl][vb] = __builtin_amdgcn_mfma_f32_16x16x32_bf16(X, Yv[vb], S[kbl][vb], 0, 0, 0); }
        }
#pragma unroll
        for (int kbl = 0; kbl < 2; ++kbl)
#pragma unroll
            for (int vb = 0; vb < 4; ++vb) { S[kbl][vb] = S[kbl][vb] * sdec; u32x2 w; w.x = pk2(S[kbl][vb][0], S[kbl][vb][1]); w.y = pk2(S[kbl][vb][2], S[kbl][vb][3]);
                *(LAS u32x2*)(St + (16 * vb + fr) * ST_P + (16 * (2 * wave + kbl) + 4 * fq) * 2) = w; }
        LBAR();
    }
#undef RET_LOAD_KV
#undef RET_LOAD_Q
    float* so = a.out + O_RP + ((size_t)(b * RH + h) * DK) * DV + sl * 64;
#pragma unroll
    for (int kbl = 0; kbl < 2; ++kbl)
#pragma unroll
        for (int vb = 0; vb < 4; ++vb)
#pragma unroll
            for (int i = 0; i < 4; ++i) so[(size_t)(16 * (2 * wave + kbl) + 4 * fq + i) * DV + 16 * vb + fr] = S[kbl][vb][i];
}

__device__ __forceinline__ void ret_sample_item(const Args& a, LAS unsigned char* lds, int item, int wave_s) {
    LAUNDER_TID();
    const int b = item >> 3, h = item & 7;
    const bf16* PROJ = (const bf16*)(a.ws + WS_PROJ); bf16* OB = (bf16*)(a.ws + WS_OB);
    LAS float* qs = (LAS float*)lds;
    LAS float* ks = qs + 1024;
    LAS float* scs = ks + 1024;
    LAS float* stat = scs + 16;
    LAS float* red = stat + 16 + 16;
    const float l2g = gamma_l2(h);
    const size_t r0 = (size_t)MP + (size_t)b * DS;
    {
        const int n = tid >> 7, c = (tid & 127) * 2;
        const unsigned wq = *(const unsigned*)(PROJ + (r0 + n) * NPROJ + h * DK + c), wk = *(const unsigned*)(PROJ + (r0 + n) * NPROJ + 2048 + h * DK + c);
        qs[n * 256 + c] = bflo(wq); qs[n * 256 + c + 1] = bfhi(wq); ks[n * 256 + c] = bflo(wk); ks[n * 256 + c + 1] = bfhi(wk);
    }
    __syncthreads();
#pragma unroll
    for (int pp = 0; pp < 2; ++pp) { const int pr = 2 * wave + pp, n = pr >> 2, m = pr & 3; float s = 0.f;
#pragma unroll
        for (int j = 0; j < 4; ++j) s += qs[n * 256 + lane + 64 * j] * ks[m * 256 + lane + 64 * j];
        s = wave_sum(s);
        if (lane == 0) scs[pr] = (m <= n) ? s * __builtin_amdgcn_exp2f((float)(n - m) * l2g) : 0.f; }
    __syncthreads();
    { const int m = tid >> 7, c = (tid & 127) * 2; const float kd = __builtin_amdgcn_exp2f((float)(3 - m) * l2g); ks[m * 256 + c] *= kd; ks[m * 256 + c + 1] *= kd; }
    __syncthreads();
    const int kq = tid >> 7, v4 = tid & 127;
    f32x4 vv[4];
#pragma unroll
    for (int m = 0; m < 4; ++m) { const u32x2 w = *(const u32x2*)(PROJ + (r0 + m) * NPROJ + 4096 + h * DV + 4 * v4); vv[m] = (f32x4){bflo(w.x), bfhi(w.x), bflo(w.y), bfhi(w.y)}; }
    const float sdec = __builtin_amdgcn_exp2f(4.f * l2g);
    const char* Sin = (const char*)(a.in[5] + ((size_t)(b * RH + h) * DK) * DV);
    char* Sout = (char*)(a.out + O_RS + ((size_t)(b * RH + h) * DK) * DV);
    const unsigned slane = (unsigned)(kq * 64 * DV + 4 * v4) * 4u;
    f32x4 oa[4];
#pragma unroll
    for (int n = 0; n < 4; ++n) oa[n] = (f32x4){0.f, 0.f, 0.f, 0.f};
    f32x4 sa[16], sb[16];
#define SLOAD(buf, g) do { _Pragma("unroll") for (int i = 0; i < 16; ++i) buf[i] = __builtin_nontemporal_load((const f32x4*)(Sin + (size_t)((g) * 16 + i) * DV * 4 + slane)); } while (0)
#define SCOMP(buf, g) do { _Pragma("unroll") for (int i = 0; i < 16; ++i) { const int k = kq * 64 + (g) * 16 + i; \
        _Pragma("unroll") for (int n = 0; n < 4; ++n) oa[n] += buf[i] * qs[n * 256 + k]; \
        f32x4 sn = buf[i] * sdec; \
        _Pragma("unroll") for (int m = 0; m < 4; ++m) sn += vv[m] * ks[m * 256 + k]; \
        __builtin_nontemporal_store(sn, (f32x4*)(Sout + (size_t)((g) * 16 + i) * DV * 4 + slane)); } } while (0)
    SLOAD(sa, 0); SLOAD(sb, 1); SCOMP(sa, 0); SLOAD(sa, 2); SCOMP(sb, 1); SLOAD(sb, 3); SCOMP(sa, 2); SCOMP(sb, 3);
#undef SLOAD
#undef SCOMP
#pragma unroll
    for (int n = 0; n < 4; ++n) *(LAS f32x4*)(red + ((kq * 4 + n) * 512 + 4 * v4)) = oa[n];
    __syncthreads();
    { const int n = tid >> 7;
        f32x4 o = *(LAS f32x4*)(red + ((0 * 4 + n) * 512 + 4 * v4)) + *(LAS f32x4*)(red + ((1 * 4 + n) * 512 + 4 * v4)) + *(LAS f32x4*)(red + ((2 * 4 + n) * 512 + 4 * v4)) + *(LAS f32x4*)(red + ((3 * 4 + n) * 512 + 4 * v4));
        o = o * __builtin_amdgcn_exp2f((float)(n + 1) * l2g);
#pragma unroll
        for (int m = 0; m < 4; ++m) o += vv[m] * scs[n * 4 + m];
        float s1 = (o[0] + o[1]) + (o[2] + o[3]), s2 = (o[0] * o[0] + o[1] * o[1]) + (o[2] * o[2] + o[3] * o[3]);
        s1 = wave_sum(s1); s2 = wave_sum(s2);
        if (lane == 0) { stat[wave * 2] = s1; stat[wave * 2 + 1] = s2; }
        __syncthreads();
        const float t1 = stat[(2 * n) * 2] + stat[(2 * n + 1) * 2], t2 = stat[(2 * n) * 2 + 1] + stat[(2 * n + 1) * 2 + 1];
        const float mu = t1 * (1.f / DV), var = t2 * (1.f / DV) - mu * mu, rstd = __builtin_amdgcn_rsqf(var + EPS);
        const u32x2 gw = *(const u32x2*)(PROJ + (r0 + n) * NPROJ + 8192 + h * DV + 4 * v4);
        u32x2 w; w.x = pk2(bflo(gw.x) * (o[0] - mu) * rstd, bfhi(gw.x) * (o[1] - mu) * rstd); w.y = pk2(bflo(gw.y) * (o[2] - mu) * rstd, bfhi(gw.y) * (o[3] - mu) * rstd);
        *(u32x2*)(OB + (r0 + n) * 4096 + h * DV + 4 * v4) = w;
    }
    __syncthreads();
}

__device__ __forceinline__ void act_fixup(const Args& a, int layer, int pm, int wave_s) {
    LAUNDER_TID();
    if ((pm & 7) == 0 || pm >= MP / 256) return;
    const float* ub = (const float*)(a.ws + WS_UBND); bf16* ACT = (bf16*)(a.ws + WS_ACT);
    const float* cw = a.in[16] + (size_t)layer * 3 * F2; const float* cb = a.in[17] + (size_t)layer * F2;
    for (int g4 = tid; g4 < FF / 4; g4 += NT) {
        const int f = 4 * g4, ug = 256 * (f >> 7) + (f & 127), uu = ug + 128;
        const float* pr = ub + (size_t)((pm - 1) * 4) * F2; const float* cu_ = ub + (size_t)(pm * 4) * F2;
        const f32x4 m2g = *(const f32x4*)(pr + 2 * F2 + ug), m1g = *(const f32x4*)(pr + 3 * F2 + ug), z0g = *(const f32x4*)(cu_ + ug), z1g = *(const f32x4*)(cu_ + F2 + ug);
        const f32x4 m2u = *(const f32x4*)(pr + 2 * F2 + uu), m1u = *(const f32x4*)(pr + 3 * F2 + uu), z0u = *(const f32x4*)(cu_ + uu), z1u = *(const f32x4*)(cu_ + F2 + uu);
        const f32x4 w0g = *(const f32x4*)(cw + f), w1g = *(const f32x4*)(cw + F2 + f), w2g = *(const f32x4*)(cw + 2 * F2 + f), bg = *(const f32x4*)(cb + f);
        const f32x4 w0u = *(const f32x4*)(cw + FF + f), w1u = *(const f32x4*)(cw + F2 + FF + f), w2u = *(const f32x4*)(cw + 2 * F2 + FF + f), bu = *(const f32x4*)(cb + FF + f);
        const f32x4 g0 = w0g * m2g + w1g * m1g + w2g * z0g + bg, u0 = w0u * m2u + w1u * m1u + w2u * z0u + bu;
        const f32x4 g1 = w0g * m1g + w1g * z0g + w2g * z1g + bg, u1 = w0u * m1u + w1u * z0u + w2u * z1u + bu;
        u32x2 o0, o1;
        o0.x = pk2(silu_f(g0[0]) * u0[0], silu_f(g0[1]) * u0[1]); o0.y = pk2(silu_f(g0[2]) * u0[2], silu_f(g0[3]) * u0[3]);
        o1.x = pk2(silu_f(g1[0]) * u1[0], silu_f(g1[1]) * u1[1]); o1.y = pk2(silu_f(g1[2]) * u1[2], silu_f(g1[3]) * u1[3]);
        *(u32x2*)(ACT + (size_t)(pm * 256) * FF + f) = o0; *(u32x2*)(ACT + (size_t)(pm * 256 + 1) * FF + f) = o1;
    }
}

__device__ __forceinline__ void gn_phase(const Args& a, int wave_s) {
    LAUNDER_TID();
    const int G = gridDim.x, gw = blockIdx.x * NWAVES + wave, NGW = G * NWAVES;
    const bf16* PROJ = (const bf16*)(a.ws + WS_PROJ); bf16* OB = (bf16*)(a.ws + WS_OB);
    for (int it0 = gw * 4; it0 < MP * RH; it0 += NGW * 4) {
        u32x4 ov[4], gv[4];
#pragma unroll
        for (int q = 0; q < 4; ++q) { const int it = it0 + q, row = it >> 3, h = it & 7;
            ov[q] = *(const u32x4*)(OB + (size_t)row * 4096 + h * DV + 8 * lane); gv[q] = *(const u32x4*)(PROJ + (size_t)row * NPROJ + 8192 + h * DV + 8 * lane); }
#pragma unroll
        for (int q = 0; q < 4; ++q) { const int it = it0 + q, row = it >> 3, h = it & 7;
            float o[8] = {bflo(ov[q].x), bfhi(ov[q].x), bflo(ov[q].y), bfhi(ov[q].y), bflo(ov[q].z), bfhi(ov[q].z), bflo(ov[q].w), bfhi(ov[q].w)};
            const float g[8] = {bflo(gv[q].x), bfhi(gv[q].x), bflo(gv[q].y), bfhi(gv[q].y), bflo(gv[q].z), bfhi(gv[q].z), bflo(gv[q].w), bfhi(gv[q].w)};
            float s1 = 0.f, s2 = 0.f;
#pragma unroll
            for (int e = 0; e < 8; ++e) { s1 += o[e]; s2 += o[e] * o[e]; }
            s1 = wave_sum(s1); s2 = wave_sum(s2);
            const float mu = s1 * (1.f / DV), var = s2 * (1.f / DV) - mu * mu, rstd = __builtin_amdgcn_rsqf(var + EPS);
#pragma unroll
            for (int e = 0; e < 8; ++e) o[e] = g[e] * (o[e] - mu) * rstd;
            u32x4 w; w.x = pk2(o[0], o[1]); w.y = pk2(o[2], o[3]); w.z = pk2(o[4], o[5]); w.w = pk2(o[6], o[7]);
            *(u32x4*)(OB + (size_t)row * 4096 + h * DV + 8 * lane) = w; }
    }
}

__device__ __forceinline__ void final_phase(const Args& a, const bf16* xs, const float* ssq, int wave_s) {
    LAUNDER_TID();
    const int G = gridDim.x, gw = blockIdx.x * NWAVES + wave, NGW = G * NWAVES;
    const float* gf = a.in[10];
    for (int row = gw; row < M; row += NGW) {
        const float rs = row_rstd(ssq, row);
#pragma unroll
        for (int j = 0; j < 4; ++j) { const int c = 8 * lane + 512 * j; const u32x4 w = *(const u32x4*)(xs + (size_t)row * D + c);
            const f32x4 g0 = *(const f32x4*)(gf + c), g1 = *(const f32x4*)(gf + c + 4);
            *(f32x4*)(a.out + (size_t)row * D + c) = (f32x4){bflo(w.x), bfhi(w.x), bflo(w.y), bfhi(w.y)} * rs * g0;
            *(f32x4*)(a.out + (size_t)row * D + c + 4) = (f32x4){bflo(w.z), bfhi(w.z), bflo(w.w), bfhi(w.w)} * rs * g1; }
    }
}

constexpr int NPH = 15;
__global__ void __launch_bounds__(NT, 2) fwd_kernel(Args args) {
    extern __shared__ __attribute__((aligned(16))) unsigned char lds_raw[];
    LAS unsigned char* lds = (LAS unsigned char*)lds_raw;
    const int tid = threadIdx.x;
    const int wave_s = __builtin_amdgcn_readfirstlane(tid >> 6);
    const int G = gridDim.x;
    unsigned char* ws = args.ws;
    for (int u = tid; u < (LDS_BYTES - LDSCTL_OFF) / 4; u += NT) ((LAS unsigned*)(lds + LDSCTL_OFF))[u] = 0u;
    __syncthreads();
    XcdBarrier bar; bar.bar = (unsigned*)(ws + WS_CTL) + CW_BAR; bar.x = 0; bar.st = nullptr;
    const int lo = args.ph_lo, hi = args.ph_hi;
    if (hi - lo > 1) bar = xcd_barrier_post((unsigned*)(ws + WS_CTL) + CW_BAR, (volatile LAS unsigned*)(lds + MISC_OFF) + 8);
#define IN(k) (lo <= (k) && (k) < hi)
#define SEAM(k) do { if (IN(k) && IN((k) + 1)) xcd_barrier(bar, wave_s); } while (0)
#define SEAM2(k, k2) do { if (IN(k) && IN(k2)) xcd_barrier(bar, wave_s); } while (0)
    float* XSA = (float*)(ws + WS_XSA); float* XSB = (float*)(ws + WS_XSB);
    bf16* XB0 = (bf16*)(ws + WS_XB0); bf16* XB1 = (bf16*)(ws + WS_XB1);
#define SSQV(k) ((float*)(ws + WS_SSQV + (k) * SSQV_STRIDE))
#define SSQO(k) SSQV(rep_ ? 6 : (k))
    pg8::StaticOrder S;

    if (IN(0)) REP(0) { p0_prologue(args, lds, wave_s); }
    SEAM(0);
#define GEMM_RUN(XT, EPI, ...) do { S.init((XT) ? MP : M, NN_, G, (int)blockIdx.x); const pg8::EPI e_ __VA_ARGS__; const pg8::EpiDrive<pg8::EPI> E(e_); pg8::gemm_phase<pg8::EpiDrive<pg8::EPI>, XT>(lds, g, S, E, wave_s); } while (0)
#define EMB_FILL(l) do { const int nu_ = (M / 256) * (F2 / 256), r_ = (nu_ + G - 1) / G, ns_ = r_ * G - nu_; \
        pg8::Gemm g{(const bf16*)(ws + WS_PB) + (size_t)(l) * M * PLE, (const bf16*)(ws + WS_WP) + (size_t)(l) * D * PLE, PLE, PLE, 0}; \
        if (ns_ > 0) S.init(MP, D, ns_, (int)blockIdx.x - (G - ns_)); else S.init(MP, D, G, (int)blockIdx.x); \
        const pg8::EpiBf16 e_{(bf16*)(ws + ((l) ? WS_EMB1 : WS_EMB0)), nullptr}; const pg8::EpiDrive<pg8::EpiBf16> E(e_); pg8::gemm_phase<pg8::EpiDrive<pg8::EpiBf16>, true>(lds, g, S, E, wave_s); } while (0)
    if (IN(1)) REP(1) {
        { constexpr int NN_ = D; pg8::Gemm g{(const bf16*)(ws + WS_DPRE), (const bf16*)(ws + WS_WPOOL), D, 512, 2}; GEMM_RUN(true, EpiRes, {args.in[0], args.in[1], nullptr, XB0, SSQO(0), args.in[12], nullptr}); }
    }
    SEAM(1);
    if (IN(2)) REP(2) { constexpr int NN_ = F2; pg8::Gemm g{XB0, (const bf16*)(ws + WS_WUP), D, D, 0}; S.init(M, NN_, G, (int)blockIdx.x); const pg8::EpiUpAct E{(bf16*)(ws + WS_ACT), SSQV(0), args.out + O_CP, args.out + O_CS, args.in[16], args.in[17], args.in[6], (float*)(ws + WS_UBND), (LAS float*)(lds + XCH_OFF)}; pg8::gemm_phase<pg8::EpiUpAct, false>(lds, g, S, E, wave_s); }
    if (IN(2)) EMB_FILL(0);
#if defined(PROBE_VAR)
    if (IN(2)) { pg8::Gemm g{XB0, (const bf16*)(ws + WS_WUP), D, D, 0}; S.init(M, F2, G, (int)blockIdx.x); const pg8::EpiBf16 e_{(bf16*)(ws + WS_U + 16 * MiB), nullptr}; const pg8::EpiDrive<pg8::EpiBf16> E(e_); pg8::gemm_phase<pg8::EpiDrive<pg8::EpiBf16>, false, PROBE_VAR>(lds, g, S, E, wave_s); }
#endif
    SEAM2(2, 4);
    if (IN(4)) REP(4) { constexpr int NN_ = D; { pg8::Unit u_; S.init(MP, D, G, (int)blockIdx.x); for (int i = 0; S.next(i, u_); ++i) act_fixup(args, 0, u_.pm, wave_s); asm volatile("s_waitcnt vmcnt(0)" ::: "memory"); __syncthreads(); }
        pg8::Gemm g{(const bf16*)(ws + WS_ACT), (const bf16*)(ws + WS_WDN), FF, FF, 0}; GEMM_RUN(true, EpiRes, {nullptr, nullptr, XB0, XB1, SSQO(1), nullptr, nullptr}); }
    SEAM(4);
    if (IN(5)) REP(5) { constexpr int NN_ = D; pg8::Gemm g{XB1, (const bf16*)(ws + WS_WG), D, D, 0}; GEMM_RUN(true, EpiPle, {XB1, (const bf16*)(ws + WS_EMB0), SSQV(1), XB0, SSQO(2)}); }
    SEAM(5);
#define STAGGER(n) do { const int sj_ = ((int)blockIdx.x >> 3) & 7; for (int si_ = 0; si_ < sj_; ++si_) __builtin_amdgcn_s_sleep(n); } while (0)
    if (IN(6)) REP(6) { constexpr int NN_ = NPROJ; STAGGER(39); pg8::Gemm g{XB0, (const bf16*)(ws + WS_WIN), D, D, 0}; GEMM_RUN(true, EpiRetIn, {(bf16*)(ws + WS_PROJ), SSQV(2), (const float*)(ws + WS_ROPE)}); }
    SEAM(6);
    if (IN(7)) REP(7) {
        const int bx = blockIdx.x, half = (bx >> 3) & 1, rank = (bx >> 4) * 8 + (bx & 7), nh = G / 2;
        if (G % 16 != 0) { for (int it = bx; it < NB * RH * 8; it += G) ret_prompt_item(args, lds, it, wave_s); __syncthreads(); for (int it = bx; it < DB * RH; it += G) ret_sample_item(args, lds, it, wave_s); }
        else if (half == 0) {
            const int prank = (G == 256) ? (((bx & 7) * 2 + (bx >> 7)) * 8 + ((bx >> 4) & 7)) : rank;
            REP(16) for (int it = prank; it < NB * RH * 8; it += nh) ret_prompt_item(args, lds, it, wave_s); }
        else { REP(17) for (int it = rank; it < DB * RH; it += nh) ret_sample_item(args, lds, it, wave_s); }
    }
    SEAM(7);
    if (IN(8)) gn_phase(args, wave_s);
    SEAM(8);
    if (IN(9)) REP(9) { constexpr int NN_ = D; pg8::Gemm g{(const bf16*)(ws + WS_OB), (const bf16*)(ws + WS_WOUT), 4096, 4096, 0}; GEMM_RUN(true, EpiRes, {nullptr, nullptr, XB0, XB1, SSQO(3), nullptr, nullptr}); }
    SEAM(9);
    if (IN(10)) REP(10) { constexpr int NN_ = F2; pg8::Gemm g{XB1, (const bf16*)(ws + WS_WUP) + (size_t)F2 * D, D, D, 0}; S.init(M, NN_, G, (int)blockIdx.x); const pg8::EpiUpAct E{(bf16*)(ws + WS_ACT), SSQV(3), args.out + O_CP + (size_t)NB * 2 * F2, args.out + O_CS + (size_t)DB * 2 * F2, args.in[16] + (size_t)3 * F2, args.in[17] + F2, args.in[6] + (size_t)DB * 2 * F2, (float*)(ws + WS_UBND), (LAS float*)(lds + XCH_OFF)}; pg8::gemm_phase<pg8::EpiUpAct, false>(lds, g, S, E, wave_s); }
    if (IN(10)) EMB_FILL(1);
    SEAM2(10, 12);
    if (IN(12)) REP(12) { constexpr int NN_ = D; { pg8::Unit u_; S.init(MP, D, G, (int)blockIdx.x); for (int i = 0; S.next(i, u_); ++i) act_fixup(args, 1, u_.pm, wave_s); asm volatile("s_waitcnt vmcnt(0)" ::: "memory"); __syncthreads(); }
        pg8::Gemm g{(const bf16*)(ws + WS_ACT), (const bf16*)(ws + WS_WDN) + (size_t)D * FF, FF, FF, 0}; GEMM_RUN(true, EpiRes, {nullptr, nullptr, XB1, XB0, SSQO(4), nullptr, nullptr}); }
    SEAM(12);
    const bool fuse_fin = (G == (MP / 256) * (D / 256));
    if (IN(13)) { constexpr int NN_ = D; pg8::Gemm g{XB0, (const bf16*)(ws + WS_WG) + (size_t)D * D, D, D, 0};
        if (fuse_fin) { S.init(MP, NN_, G, (int)blockIdx.x);
            const pg8::EpiPleFin E{XB0, (const bf16*)(ws + WS_EMB1), SSQV(4), SSQV(5), args.in[10], args.out, (unsigned*)(ws + WS_CTL) + CW_PCNT, (unsigned*)(ws + WS_CTL)};
            pg8::gemm_phase<pg8::EpiPleFin, true>(lds, g, S, E, wave_s); }
        else { const int rep_ = 0; (void)rep_; GEMM_RUN(true, EpiPle, {XB0, (const bf16*)(ws + WS_EMB1), SSQV(4), XB1, SSQV(5)}); } }
    if (!fuse_fin) { SEAM(13);
        if (IN(14)) final_phase(args, XB1, SSQV(5), wave_s); }
#undef IN
#undef SEAM
}

extern "C" void kernel_launch(void* const* d_in, const int* in_sizes, int n_in, void* d_out, int out_size, void* d_ws, size_t ws_size, hipStream_t stream) {
    static int grid = 0;
    if (grid == 0) {
        if (n_in != 21 || (size_t)out_size != O_END || ws_size < WS_END) { fprintf(stderr, "kernel_launch: unexpected sizes n_in %d out %d ws %zu\n", n_in, out_size, ws_size); grid = -1; return; }
        int dev = 0, cus = 0, per_cu = 0;
        if (hipGetDevice(&dev) != hipSuccess || hipDeviceGetAttribute(&cus, hipDeviceAttributeMultiprocessorCount, dev) != hipSuccess) { grid = -1; return; }
        if (hipFuncSetAttribute((const void*)fwd_kernel, hipFuncAttributeMaxDynamicSharedMemorySize, LDS_BYTES) != hipSuccess) { fprintf(stderr, "kernel_launch: hipFuncSetAttribute failed\n"); grid = -1; return; }
        if (hipOccupancyMaxActiveBlocksPerMultiprocessor(&per_cu, (const void*)fwd_kernel, NT, LDS_BYTES) != hipSuccess || per_cu < 1) { fprintf(stderr, "kernel_launch: occupancy query says %d\n", per_cu); }
        (void)hipGetLastError();
        grid = cus;
    }
    if (grid < 0) return;
    if (hipMemsetAsync((char*)d_ws + WS_CTL, 0, CTL_ZERO_BYTES, stream) != hipSuccess) return;
    Args a{};
    for (int i = 0; i < 21; ++i) a.in[i] = (const float*)d_in[i];
    a.out = (float*)d_out; a.ws = (unsigned char*)d_ws;
#if MK_ONE_LAUNCH
    a.ph_lo = 0; a.ph_hi = NPH;
    hipLaunchKernelGGL(fwd_kernel, dim3(grid), dim3(NT), LDS_BYTES, stream, a);
#else
    for (int p = 0; p < NPH; ++p) { a.ph_lo = p; a.ph_hi = p + 1; hipLaunchKernelGGL(fwd_kernel, dim3(grid), dim3(NT), LDS_BYTES, stream, a); }
#endif
}
```

```cpp
#include <hip/hip_runtime.h>
#include <cstdio>
#include <cstdint>

#ifndef MK_ONE_LAUNCH
#define MK_ONE_LAUNCH 1
#endif

#ifndef PROBE_DUP
#define PROBE_DUP 0
#endif
#define REP(k) _Pragma("unroll") for (int rep_ = 0; rep_ < 1 + ((PROBE_DUP >> (k)) & 1); ++rep_)
#define LAS __attribute__((address_space(3)))
#define GAS __attribute__((address_space(1)))
typedef unsigned short bf16;
typedef short bf16x8 __attribute__((ext_vector_type(8)));
typedef short s16x4 __attribute__((ext_vector_type(4)));
typedef float f32x4 __attribute__((ext_vector_type(4)));
typedef float f32x2 __attribute__((ext_vector_type(2)));
typedef unsigned u32x4 __attribute__((ext_vector_type(4)));
typedef unsigned u32x2 __attribute__((ext_vector_type(2)));
typedef GAS unsigned gu32;

constexpr int D = 2048, NB = 4, SEQ = 2048, DB = 128, DS = 4;
constexpr int MP = NB * SEQ, MS = DB * DS, M = MP + MS;
constexpr int FF = 5632, F2 = 2 * FF, PLE = 256;
constexpr int RH = 8, DK = 256, DV = 512, NPROJ = 12288;
constexpr int PBUF = 15, PAST = 16384, NPOS = SEQ + DS;
constexpr float EPS = 1e-6f;
constexpr int NWAVES = 8, NT = NWAVES * 64;

constexpr size_t O_YP = 0, O_YS = (size_t)MP * D, O_PP = O_YS + (size_t)MS * D, O_PS = O_PP + (size_t)NB * PBUF * D,
                 O_RP = O_PS + (size_t)DB * PBUF * D, O_RS = O_RP + (size_t)NB * RH * DK * DV, O_CP = O_RS + (size_t)DB * RH * DK * DV,
                 O_CS = O_CP + (size_t)2 * NB * 2 * F2, O_END = O_CS + (size_t)2 * DB * 2 * F2;

constexpr size_t MiB = 1u << 20;
constexpr size_t WS_CTL = 0, CTL_ZERO_BYTES = 1 * MiB;
constexpr size_t WS_ROPE = 2 * MiB;
constexpr size_t WS_SSQV = 65536, SSQV_STRIDE = 36864;
constexpr size_t WS_WPOOL = 16 * MiB;
constexpr size_t WS_WP = 18 * MiB;
constexpr size_t WS_WG = 20 * MiB;
constexpr size_t WS_WUP = 36 * MiB;
constexpr size_t WS_WDN = 124 * MiB;
constexpr size_t WS_WIN = 168 * MiB;
constexpr size_t WS_WOUT = 216 * MiB;
constexpr size_t WS_PB = 240 * MiB;
constexpr size_t WS_DPRE = 250 * MiB;
constexpr size_t WS_EMB0 = 284 * MiB, WS_EMB1 = 318 * MiB;
constexpr size_t WS_XSA = 352 * MiB, WS_XSB = 420 * MiB;
constexpr size_t WS_XB0 = 488 * MiB, WS_XB1 = 522 * MiB;
constexpr size_t WS_U = 560 * MiB;
constexpr size_t WS_UBND = 560 * MiB;
constexpr size_t WS_ACT = 748 * MiB;
constexpr size_t WS_PROJ = 842 * MiB;
constexpr size_t WS_OB = 1046 * MiB;
constexpr size_t WS_END = 1114 * MiB;
static_assert(WS_WPOOL + (size_t)2048 * 512 * 2 <= WS_WP && WS_WP + (size_t)2 * 2048 * 256 * 2 <= WS_WG && WS_WG + (size_t)2 * 2048 * 2048 * 2 <= WS_WUP &&
              WS_WUP + (size_t)2 * F2 * D * 2 <= WS_WDN && WS_WDN + (size_t)2 * D * FF * 2 <= WS_WIN && WS_WIN + (size_t)NPROJ * D * 2 <= WS_WOUT && WS_WOUT + (size_t)D * 4096 * 2 <= WS_PB, "ws weights");
static_assert(WS_PB + (size_t)2 * M * PLE * 2 <= WS_DPRE && WS_DPRE + (size_t)M * D * 2 <= WS_EMB0 && WS_EMB0 + (size_t)M * D * 2 <= WS_EMB1 && WS_EMB1 + (size_t)M * D * 2 <= WS_XSA &&
              WS_XSA + (size_t)M * D * 4 <= WS_XSB && WS_XSB + (size_t)M * D * 4 <= WS_XB0 && WS_XB0 + (size_t)M * D * 2 <= WS_XB1 && WS_XB1 + (size_t)M * D * 2 <= WS_U &&
              WS_U + (size_t)M * F2 * 2 <= WS_ACT && WS_ACT + (size_t)M * FF * 2 <= WS_PROJ && WS_PROJ + (size_t)M * NPROJ * 2 <= WS_OB && WS_OB + (size_t)M * 4096 * 2 <= WS_END, "ws activations");
static_assert(WS_ROPE + (size_t)2 * NPOS * 128 * 4 <= WS_WPOOL && WS_SSQV + 7 * SSQV_STRIDE <= CTL_ZERO_BYTES && (size_t)M * 4 <= SSQV_STRIDE, "ws tables");
constexpr int CW_BAR = 4096, CW_PCNT = 8192;

constexpr int RING_BYTES = 131072, XA_BYTES = 4096, LDSCTL_OFF = RING_BYTES + XA_BYTES, MISC_OFF = LDSCTL_OFF + 320, XCH_OFF = LDSCTL_OFF + 1024, XCH_BYTES = 8192, LDS_BYTES = 147456;

__device__ __forceinline__ unsigned f2bf(float f) { unsigned u = __builtin_bit_cast(unsigned, f); return (u + 0x7fffu + ((u >> 16) & 1u)) >> 16; }
__device__ __forceinline__ unsigned pk2(float lo, float hi) { unsigned r; asm("v_cvt_pk_bf16_f32 %0, %1, %2" : "=v"(r) : "v"(lo), "v"(hi)); return r; }
__device__ __forceinline__ float bflo(unsigned w) { return __builtin_bit_cast(float, w << 16); }
__device__ __forceinline__ float bfhi(unsigned w) { return __builtin_bit_cast(float, w & 0xffff0000u); }
__device__ __forceinline__ float wave_sum(float v) {
#pragma unroll
    for (int o = 1; o < 64; o <<= 1) v += __shfl_xor(v, o);
    return v;
}
__device__ __forceinline__ float gamma_l2(int h) {
    float v = -4.580368961e-02f;
    v = (h == 1) ? -2.272007650e-02f : v; v = (h == 2) ? -1.131531323e-02f : v; v = (h == 3) ? -5.646563141e-03f : v; v = (h == 4) ? -2.820519062e-03f : v;
    v = (h == 5) ? -1.409570255e-03f : v; v = (h == 6) ? -7.046129766e-04f : v; v = (h == 7) ? -3.522634716e-04f : v;
    return v;
}
__device__ __forceinline__ float silu_f(float x) { return x * __builtin_amdgcn_rcpf(1.f + __expf(-x)); }
__device__ __forceinline__ float sigmoid_f(float x) { return __builtin_amdgcn_rcpf(1.f + __expf(-x)); }
__device__ __forceinline__ float row_rstd(const float* ssq, int row) { return __builtin_amdgcn_rsqf(ssq[row] * (1.f / D) + EPS); }

namespace pg8 {
constexpr int BM = 256, BK = 64, HALF = 128, HTB = HALF * BK * 2, STAGE_BYTES = 8 * HTB, NXCD = 8, WGM = 8;
__host__ __device__ __forceinline__ int lds_byte(int r, int c) { const int st = (r >> 4) * 2 + (c >> 5), rr = r & 15, cc = c & 31, ob = rr * 64 + cc * 2; return st * 1024 + (ob ^ (((ob >> 9) & 1) << 5)); }
__host__ __device__ __forceinline__ void stage_rc(int b, int& R, int& C) { const int st = b / 1024, sb = b % 1024, swz = sb ^ (((sb >> 9) & 1) << 5); R = (st >> 1) * 16 + swz / 64; C = (st & 1) * 32 + (swz % 64) / 2; }
__host__ __device__ __forceinline__ int perm32(int rho) { const int n = rho >> 4, i = rho & 15; return 8 * (i >> 2) + 4 * n + (i & 3); }
struct Unit { int pm, pn; };
struct Gemm { const bf16* A; const bf16* Bt; int lda, K, grp; };
struct StaticOrder {
    int nM, nN, nwg, G, c;
    __host__ __device__ __forceinline__ void init(int M_, int N_, int G_, int c_) { nM = M_ / BM; nN = N_ / BM; nwg = nM * nN; G = G_; c = c_; }
    __host__ __device__ __forceinline__ bool next(int i, Unit& u) const {
        if (c < 0) return false;
        const long L = (long)i * G + c; if (L >= nwg) return false;
        int wgid = (int)L; { const int q = nwg / NXCD, r = nwg % NXCD, xcd = wgid % NXCD, off = wgid / NXCD; wgid = (xcd < r ? xcd * (q + 1) : r * (q + 1) + (xcd - r) * q) + off; }
        const int nig = WGM * nN, gid = wgid / nig, fm = gid * WGM, gsz = (nM - fm) < WGM ? (nM - fm) : WGM;
        u.pm = fm + ((wgid % nig) % gsz); u.pn = (wgid % nig) / gsz; return true;
    }
};
template <class Epi, bool XT, int VAR = 0>
__device__ __forceinline__ void gemm_phase(LAS unsigned char* lds, const Gemm g, const StaticOrder& S, const Epi& E, int wave_s) {
    const int wid = __builtin_amdgcn_readfirstlane(wave_s); int lane = (int)__builtin_amdgcn_mbcnt_hi(~0u, __builtin_amdgcn_mbcnt_lo(~0u, 0u)); asm volatile("" : "+v"(lane));
    const int tid = wid * 64 + lane, wr = wid >> 2, wc = wid & 3, fr = lane & 15, fq = lane >> 4;
    int K = g.K, lda = g.lda; asm volatile("" : "+s"(K), "+s"(lda));
    const int nt = K / BK;
    unsigned voffA[2], voffB[2], voffX = 0;
#pragma unroll
    for (int i = 0; i < 2; ++i) { int R, C; stage_rc(tid * 16 + i * 8192, R, C); const int Rb = (R & ~31) + perm32(R & 31);
        voffA[i] = (unsigned)(R * lda + C) * 2u; voffB[i] = (unsigned)(Rb * K + C) * 2u; }
    if (XT) { int R, C; stage_rc(wid * 256 + fr * 16, R, C); voffX = (unsigned)(R * lda + C) * 2u; }
    const unsigned kstep = (unsigned)(BK * 2);
    const unsigned hA = (unsigned)HALF * lda * 2, hB = (unsigned)HALF * K * 2, tA = 2 * hA, tB = 2 * hB, tX = (unsigned)16 * lda * 2, xbase = (unsigned)MP * lda * 2;
    const __amdgpu_buffer_rsrc_t rsA = __builtin_amdgcn_make_buffer_rsrc((void*)g.A, 0, 0xFFFFFFF0u, 0x00020000), rsB = __builtin_amdgcn_make_buffer_rsrc((void*)g.Bt, 0, 0xFFFFFFF0u, 0x00020000);
    const unsigned ldsw = (unsigned)wid * 1024u;
    const int aoff = lds_byte(wr * 64 + fr, fq * 8), boff = lds_byte(wc * 32 + fr, fq * 8), xoff = lds_byte(fr, fq * 8);
#define PG8_SA(b, h) (((b) * 2 + (h)) * HTB)
#define PG8_SB(b, h) ((4 + (b) * 2 + (h)) * HTB)
#define PG8_XA(b) (STAGE_BYTES + (b) * 2048)
#define PG8_STAGE(bufoff, rs, soff, voff) do { if constexpr (VAR != 3) _Pragma("unroll") for (int _i = 0; _i < 2; ++_i) \
        __builtin_amdgcn_raw_ptr_buffer_load_lds(rs, (LAS unsigned*)(lds + (bufoff) + ldsw + _i * 8192), 16, (voff)[_i], (soff), 0, 0); } while (0)
#define PG8_STAGEX(b, soff) do { if constexpr (XT) { if (lane < 16) \
        __builtin_amdgcn_raw_ptr_buffer_load_lds(rsA, (LAS unsigned*)(lds + PG8_XA(b) + wid * 256), 16, voffX, (soff), 0, 0); } } while (0)
#define PG8_LDA(dst, b, h) do { if constexpr (VAR != 1) _Pragma("unroll") for (int m = 0; m < 4; ++m) _Pragma("unroll") for (int k = 0; k < 2; ++k) dst[m][k] = *(const LAS bf16x8*)(lds + PG8_SA(b, h) + aoff + m * 2048 + k * 1024); } while (0)
#define PG8_LDB(dst, b, h) do { if constexpr (VAR != 1) _Pragma("unroll") for (int n = 0; n < 2; ++n) _Pragma("unroll") for (int k = 0; k < 2; ++k) dst[n][k] = *(const LAS bf16x8*)(lds + PG8_SB(b, h) + boff + n * 2048 + k * 1024); } while (0)
#define PG8_LDX(b) do { if constexpr (XT) { _Pragma("unroll") for (int k = 0; k < 2; ++k) Ax[k] = *(const LAS bf16x8*)(lds + PG8_XA(b) + xoff + k * 1024); } } while (0)
#define PG8_MMA(ai, bj, At, Bt) do { if constexpr (VAR < 4 || VAR == 9) __builtin_amdgcn_s_setprio(1); \
        if constexpr (VAR == 9) { _Pragma("unroll") for (int m = 0; m < 4; ++m) _Pragma("unroll") for (int k = 0; k < 2; ++k) acc32[ai][bj][m >> 1] = __builtin_amdgcn_mfma_f32_32x32x16_bf16(Bt[m & 1][k], At[m][k], acc32[ai][bj][m >> 1], 0, 0, 0); } \
        else if constexpr (VAR != 2) _Pragma("unroll") for (int m = 0; m < 4; ++m) _Pragma("unroll") for (int n = 0; n < 2; ++n) _Pragma("unroll") for (int k = 0; k < 2; ++k) \
        acc[ai][bj][m][n] = __builtin_amdgcn_mfma_f32_16x16x32_bf16(Bt[n][k], At[m][k], acc[ai][bj][m][n], 0, 0, 0); if constexpr (VAR < 4 || VAR == 9) __builtin_amdgcn_s_setprio(0); } while (0)
#define PG8_MMAX() do { if constexpr (XT) { if (wr == 0) { _Pragma("unroll") for (int k = 0; k < 2; ++k) { accx[0] = __builtin_amdgcn_mfma_f32_16x16x32_bf16(B0[0][k], Ax[k], accx[0], 0, 0, 0); accx[1] = __builtin_amdgcn_mfma_f32_16x16x32_bf16(B1[0][k], Ax[k], accx[1], 0, 0, 0); } } \
        else { _Pragma("unroll") for (int k = 0; k < 2; ++k) { accx[0] = __builtin_amdgcn_mfma_f32_16x16x32_bf16(B0[1][k], Ax[k], accx[0], 0, 0, 0); accx[1] = __builtin_amdgcn_mfma_f32_16x16x32_bf16(B1[1][k], Ax[k], accx[1], 0, 0, 0); } } } } while (0)
#define PG8_WAIT_V(n) asm volatile("s_waitcnt vmcnt(" #n ")" ::: "memory")
#define PG8_WAIT_VL() do { if constexpr (XT) PG8_WAIT_V(9); else PG8_WAIT_V(8); } while (0)
#define PG8_WAIT_L(n) asm volatile("s_waitcnt lgkmcnt(" #n ")" ::: "memory")
#define PG8_BAR __builtin_amdgcn_s_barrier()
#define PG8_SCHED __builtin_amdgcn_sched_barrier(0)
    Unit cur, nxt; int ui = 0;
    if (!S.next(0, cur)) return;
    if constexpr (VAR == 5) { if (wr == 1) __builtin_amdgcn_s_setprio(1); }
    f32x4 acc[2][2][4][2]; f32x4 accx[2];
    typedef float f32x16 __attribute__((ext_vector_type(16)));
    f32x16 acc32[2][2][2];
    if constexpr (VAR == 9) { _Pragma("unroll") for (int a_ = 0; a_ < 2; ++a_) _Pragma("unroll") for (int b_ = 0; b_ < 2; ++b_) _Pragma("unroll") for (int c_ = 0; c_ < 2; ++c_) _Pragma("unroll") for (int e_ = 0; e_ < 16; ++e_) acc32[a_][b_][c_][e_] = 0.f; }
#pragma unroll
    for (int a = 0; a < 2; ++a)
#pragma unroll
        for (int b = 0; b < 2; ++b)
#pragma unroll
            for (int m = 0; m < 4; ++m)
#pragma unroll
                for (int n = 0; n < 2; ++n) acc[a][b][m][n] = (f32x4){0.f, 0.f, 0.f, 0.f};
    accx[0] = (f32x4){0.f, 0.f, 0.f, 0.f}; accx[1] = (f32x4){0.f, 0.f, 0.f, 0.f};
    bf16x8 At[4][2], B0[2][2], B1[2][2], Ax[2];
    if constexpr (VAR == 1) { const bf16x8 z_ = (bf16x8){(short)lane, 1, 2, 3, 4, 5, 6, 7};
        _Pragma("unroll") for (int m = 0; m < 4; ++m) { At[m][0] = z_; At[m][1] = z_; } _Pragma("unroll") for (int n = 0; n < 2; ++n) { B0[n][0] = z_; B0[n][1] = z_; B1[n][0] = z_; B1[n][1] = z_; } }
    const unsigned acol0 = g.grp ? (unsigned)(cur.pn / g.grp) * K * 2 : 0u;
    unsigned cA = (unsigned)cur.pm * tA + acol0, cB = (unsigned)cur.pn * tB, cX = xbase + (unsigned)cur.pm * tX + acol0;
    PG8_STAGE(PG8_SB(0, 0), rsB, cB, voffB); PG8_STAGE(PG8_SB(0, 1), rsB, cB + hB, voffB); PG8_STAGE(PG8_SA(0, 0), rsA, cA, voffA); PG8_STAGEX(0, cX); PG8_STAGE(PG8_SA(0, 1), rsA, cA + hA, voffA);
    if (wr == 1) PG8_BAR;
    PG8_WAIT_V(2); PG8_BAR;
    PG8_STAGE(PG8_SB(1, 0), rsB, cB + kstep, voffB); PG8_STAGE(PG8_SA(1, 0), rsA, cA + kstep, voffA); PG8_STAGE(PG8_SB(1, 1), rsB, cB + hB + kstep, voffB); PG8_STAGEX(1, cX + kstep);
    if constexpr (XT) PG8_WAIT_V(7); else PG8_WAIT_V(6);
    PG8_BAR;
    for (;;) {
        const bool has_next = S.next(ui + 1, nxt);
        const unsigned acoln = (has_next && g.grp) ? (unsigned)(nxt.pn / g.grp) * K * 2 : 0u;
        const unsigned nA = has_next ? (unsigned)nxt.pm * tA + acoln : cA;
        const unsigned nB = has_next ? (unsigned)nxt.pn * tB : cB;
        const unsigned nX = has_next ? xbase + (unsigned)nxt.pm * tX + acoln : cX;
        for (int t = 0; t < nt; t += 2) {
            const bool last = (t == nt - 2);
            const unsigned a1 = cA + (unsigned)(t + 1) * kstep;
            const unsigned a2 = last ? nA : cA + (unsigned)(t + 2) * kstep, b2 = last ? nB : cB + (unsigned)(t + 2) * kstep, x2 = last ? nX : cX + (unsigned)(t + 2) * kstep;
            const unsigned a3 = a2 + kstep, b3 = b2 + kstep, x3 = x2 + kstep;
            PG8_LDB(B0, 0, 0); PG8_LDB(B1, 0, 1); PG8_SCHED; PG8_LDA(At, 0, 0); PG8_LDX(0); PG8_STAGE(PG8_SA(1, 1), rsA, a1 + hA, voffA);
            PG8_WAIT_VL(); PG8_WAIT_L(0); PG8_BAR; PG8_MMA(0, 0, At, B0); PG8_MMA(0, 1, At, B1); PG8_MMAX(); PG8_BAR; PG8_SCHED;
            PG8_LDA(At, 0, 1); PG8_STAGE(PG8_SB(0, 0), rsB, b2, voffB); PG8_STAGE(PG8_SB(0, 1), rsB, b2 + hB, voffB); PG8_STAGE(PG8_SA(0, 0), rsA, a2, voffA); PG8_STAGEX(0, x2);
            PG8_WAIT_VL(); PG8_WAIT_L(0); PG8_BAR; PG8_MMA(1, 0, At, B0); PG8_MMA(1, 1, At, B1); PG8_BAR; PG8_SCHED;
            PG8_LDB(B0, 1, 0); PG8_LDB(B1, 1, 1); PG8_SCHED; PG8_LDA(At, 1, 0); PG8_LDX(1); PG8_STAGE(PG8_SA(0, 1), rsA, a2 + hA, voffA);
            PG8_WAIT_VL(); PG8_WAIT_L(0); PG8_BAR; PG8_MMA(0, 0, At, B0); PG8_MMA(0, 1, At, B1); PG8_MMAX(); PG8_BAR; PG8_SCHED;
            PG8_LDA(At, 1, 1); PG8_STAGE(PG8_SB(1, 0), rsB, b3, voffB); PG8_STAGE(PG8_SB(1, 1), rsB, b3 + hB, voffB); PG8_STAGE(PG8_SA(1, 0), rsA, a3, voffA); PG8_STAGEX(1, x3);
            PG8_WAIT_VL(); PG8_WAIT_L(0); PG8_BAR; PG8_MMA(1, 0, At, B0); PG8_MMA(1, 1, At, B1); PG8_BAR; PG8_SCHED;
        }
        if (wr == 0) PG8_BAR;
        if constexpr (VAR == 9) { _Pragma("unroll") for (int a_ = 0; a_ < 2; ++a_) _Pragma("unroll") for (int b_ = 0; b_ < 2; ++b_) _Pragma("unroll") for (int c_ = 0; c_ < 2; ++c_) _Pragma("unroll") for (int e_ = 0; e_ < 16; ++e_) { acc[a_][b_][2 * c_ + (e_ >> 3)][(e_ >> 2) & 1][e_ & 3] = acc32[a_][b_][c_][e_]; acc32[a_][b_][c_][e_] = 0.f; } }
        E.tile(acc, cur, wr, wc, fr, fq);
        if constexpr (XT) E.strip(accx, cur, wr, wc, fr, fq);
        if constexpr (Epi::FIN) E.finish(acc, accx, cur, wr, wc, fr, fq, wid);
        if (!has_next) break;
#pragma unroll
        for (int a = 0; a < 2; ++a)
#pragma unroll
            for (int b = 0; b < 2; ++b)
#pragma unroll
                for (int m = 0; m < 4; ++m)
#pragma unroll
                    for (int n = 0; n < 2; ++n) acc[a][b][m][n] = (f32x4){0.f, 0.f, 0.f, 0.f};
        accx[0] = (f32x4){0.f, 0.f, 0.f, 0.f}; accx[1] = (f32x4){0.f, 0.f, 0.f, 0.f};
        cur = nxt; cA = nA; cB = nB; cX = nX; ++ui;
        if (wr == 1) PG8_BAR;
    }
    PG8_WAIT_V(0);
    PG8_BAR;
    if constexpr (VAR == 5) __builtin_amdgcn_s_setprio(0);
#undef PG8_SA
#undef PG8_SB
#undef PG8_XA
#undef PG8_STAGE
#undef PG8_STAGEX
#undef PG8_LDA
#undef PG8_LDB
#undef PG8_LDX
#undef PG8_MMA
#undef PG8_MMAX
#undef PG8_WAIT_V
#undef PG8_WAIT_VL
#undef PG8_WAIT_L
#undef PG8_BAR
#undef PG8_SCHED
}

typedef f32x4 Acc[2][2][4][2];
template <int NV> struct PackT;
template <> struct PackT<2> { typedef u32x4 T; static __device__ __forceinline__ T pack(const f32x4* v) { T w; w.x = pk2(v[0][0], v[0][1]); w.y = pk2(v[0][2], v[0][3]); w.z = pk2(v[1][0], v[1][1]); w.w = pk2(v[1][2], v[1][3]); return w; }
    static __device__ __forceinline__ void unpack(T w, f32x4* v) { v[0] = (f32x4){bflo(w.x), bfhi(w.x), bflo(w.y), bfhi(w.y)}; v[1] = (f32x4){bflo(w.z), bfhi(w.z), bflo(w.w), bfhi(w.w)}; } };
template <> struct PackT<1> { typedef u32x2 T; static __device__ __forceinline__ T pack(const f32x4* v) { T w; w.x = pk2(v[0][0], v[0][1]); w.y = pk2(v[0][2], v[0][3]); return w; }
    static __device__ __forceinline__ void unpack(T w, f32x4* v) { v[0] = (f32x4){bflo(w.x), bfhi(w.x), bflo(w.y), bfhi(w.y)}; } };
template <int NV> __device__ __forceinline__ float sumsq(const f32x4* v) { float s = 0.f;
#pragma unroll
    for (int n = 0; n < NV; ++n) s += (v[n][0] * v[n][0] + v[n][1] * v[n][1]) + (v[n][2] * v[n][2] + v[n][3] * v[n][3]);
    return s; }

template <class T> __device__ __forceinline__ T ldg(const void* base, unsigned byteoff) { return *(const T*)((const char*)base + (size_t)byteoff); }
template <class T> __device__ __forceinline__ void stg(void* base, unsigned byteoff, T v) { *(T*)((char*)base + (size_t)byteoff) = v; }
template <class Epi> struct EpiDrive : Epi {
    static constexpr bool FIN = false;
    __device__ __forceinline__ EpiDrive(const Epi& e) : Epi(e) {}
    __device__ __forceinline__ void tile(const Acc& acc, const Unit& u, int wr, int wc, int fr, int fq) const {
        const int row0 = u.pm * BM + wr * 64 + fr, cseg = wc * 32 + 8 * fq; const bool smp = u.pm >= MP / BM;
        float rsv[2][4];
        if (Epi::RSTD) {
#pragma unroll
            for (int ai = 0; ai < 2; ++ai)
#pragma unroll
                for (int m = 0; m < 4; ++m) rsv[ai][m] = ldg<float>(this->ssq_in, (unsigned)(row0 + ai * HALF + m * 16) * 4u); }
        if constexpr (Epi::PRE > 0) {
#pragma unroll
            for (int ai = 0; ai < 2; ++ai)
#pragma unroll
              for (int mb = 0; mb < 4; mb += Epi::PB) { f32x4 buf[Epi::PB][Epi::PRE];
#pragma unroll
                for (int m = 0; m < Epi::PB; ++m) this->template pre<2>(row0 + ai * HALF + (mb + m) * 16, cseg, u.pn, smp, buf[m]);
#pragma unroll
                for (int m = 0; m < Epi::PB; ++m) { const float rs = Epi::RSTD ? __builtin_amdgcn_rsqf(rsv[ai][mb + m] * (1.f / D) + EPS) : 1.f;
                    this->template seg<2>(row0 + ai * HALF + (mb + m) * 16, cseg, u.pn, acc[ai][0][mb + m], acc[ai][1][mb + m], rs, smp, buf[m]); } }
        } else {
#pragma unroll
            for (int ai = 0; ai < 2; ++ai)
#pragma unroll
                for (int m = 0; m < 4; ++m) { const float rs = Epi::RSTD ? __builtin_amdgcn_rsqf(rsv[ai][m] * (1.f / D) + EPS) : 1.f;
                    this->template seg<2>(row0 + ai * HALF + m * 16, cseg, u.pn, acc[ai][0][m], acc[ai][1][m], rs, smp, nullptr); }
        }
    }
    __device__ __forceinline__ void strip(const f32x4 (&accx)[2], const Unit& u, int wr, int wc, int fr, int fq) const {
        const int row = MP + 16 * u.pm + fr, cseg = wc * 32 + 8 * fq + 4 * wr;
        const float rs = Epi::RSTD ? __builtin_amdgcn_rsqf(ldg<float>(this->ssq_in, (unsigned)row * 4u) * (1.f / D) + EPS) : 1.f;
        if constexpr (Epi::PRE > 0) { f32x4 buf[Epi::PRE]; this->template pre<1>(row, cseg, u.pn, true, buf); this->template seg<1>(row, cseg, u.pn, &accx[0], &accx[1], rs, true, buf); }
        else this->template seg<1>(row, cseg, u.pn, &accx[0], &accx[1], rs, true, nullptr);
    }
};

struct EpiBf16 {
    static constexpr bool RSTD = false; static constexpr int PRE = 0, PB = 1;
    bf16* O; const float* ssq_in;
    template <int NV> __device__ __forceinline__ void seg(int row, int cseg, int pn, const f32x4* v0, const f32x4* v1, float, bool, const f32x4*) const {
        const unsigned ob = (unsigned)(row * D + pn * BM + cseg) * 2u;
        stg(O, ob, PackT<NV>::pack(v0)); stg(O, ob + HALF * 2, PackT<NV>::pack(v1));
    }
};

struct EpiRes {
    static constexpr bool RSTD = false; static constexpr int PRE = 4, PB = 4;
    const float* xinP; const float* xinS; const bf16* xbin;
    bf16* xb; float* ssq_out; const float* colscale; const float* ssq_in;
    template <int NV> __device__ __forceinline__ void pre(int row, int cseg, int pn, bool smp, f32x4* buf) const {
        const unsigned oe = (unsigned)(row * D + pn * BM + cseg);
        if (xbin) {
#pragma unroll
            for (int bj = 0; bj < 2; ++bj) {
                if (NV == 2) buf[bj] = __builtin_bit_cast(f32x4, ldg<u32x4>(xbin, (oe + bj * HALF) * 2u));
                else { const u32x2 e2 = ldg<u32x2>(xbin, (oe + bj * HALF) * 2u); buf[bj] = __builtin_bit_cast(f32x4, (u32x4){e2.x, e2.y, 0u, 0u}); } }
        } else {
            const float* xin = smp ? xinS - (size_t)MP * D : xinP;
#pragma unroll
            for (int bj = 0; bj < 2; ++bj)
#pragma unroll
                for (int n = 0; n < NV; ++n) buf[bj * 2 + n] = ldg<f32x4>(xin, (oe + bj * HALF + 4 * n) * 4u);
        }
    }
    template <int NV> __device__ __forceinline__ void seg(int row, int cseg, int pn, const f32x4* v0, const f32x4* v1, float, bool, const f32x4* buf) const {
        const unsigned oe = (unsigned)(row * D + pn * BM + cseg);
        float ss = 0.f;
#pragma unroll
        for (int bj = 0; bj < 2; ++bj) { const f32x4* v = bj ? v1 : v0; f32x4 r[NV], x[2];
            if (xbin) { const u32x4 w = __builtin_bit_cast(u32x4, buf[bj]); x[0] = (f32x4){bflo(w.x), bfhi(w.x), bflo(w.y), bfhi(w.y)}; x[1] = (f32x4){bflo(w.z), bfhi(w.z), bflo(w.w), bfhi(w.w)}; }
            else { x[0] = buf[bj * 2]; x[1] = buf[bj * 2 + 1]; }
#pragma unroll
            for (int n = 0; n < NV; ++n) { f32x4 a = v[n]; if (colscale) a = a * ldg<f32x4>(colscale, (unsigned)(pn * BM + cseg + bj * HALF + 4 * n) * 4u);
                r[n] = x[n] + a; }
            stg(xb, (oe + bj * HALF) * 2u, PackT<NV>::pack(r)); ss += sumsq<NV>(r); }
        ss += __shfl_xor(ss, 16); ss += __shfl_xor(ss, 32);
        if ((__builtin_amdgcn_mbcnt_hi(~0u, __builtin_amdgcn_mbcnt_lo(~0u, 0u)) >> 4) == 0u) unsafeAtomicAdd(ssq_out + row, ss);
    }
};

struct EpiUp {
    static constexpr bool RSTD = true; static constexpr int PRE = 0, PB = 1;
    bf16* U; const float* ssq_in; float* convP; float* convS;
    template <int NV> __device__ __forceinline__ void seg(int row, int cseg, int pn, const f32x4* v0, const f32x4* v1, float rs, bool smp, const f32x4*) const {
        float* cbase = smp ? convS : convP;
        int crow = -1;
        if (!smp) { const int t = row & (SEQ - 1); if (t >= SEQ - 2) crow = (row >> 11) * 2 + (t - (SEQ - 2)); }
        else { const int s_ = row - MP, t = s_ & 3; if (t >= 2) crow = (s_ >> 2) * 2 + (t - 2); }
        const unsigned ub = (unsigned)(row * F2 + pn * BM + cseg) * 2u;
#pragma unroll
        for (int bj = 0; bj < 2; ++bj) { const f32x4* v = bj ? v1 : v0; f32x4 r[NV];
#pragma unroll
            for (int n = 0; n < NV; ++n) r[n] = v[n] * rs;
            stg(U, ub + bj * HALF * 2, PackT<NV>::pack(r));
            if (crow >= 0) {
#pragma unroll
                for (int n = 0; n < NV; ++n) stg(cbase, (unsigned)(crow * F2 + bj * FF + pn * HALF + cseg + 4 * n) * 4u, r[n]); } }
    }
};

struct EpiPle {
    static constexpr bool RSTD = true; static constexpr int PRE = 4, PB = 4;
    const bf16* xbin; const bf16* emb; const float* ssq_in; bf16* xb; float* ssq_out;
    template <int NV> __device__ __forceinline__ void pre(int row, int cseg, int pn, bool, f32x4* buf) const {
        const unsigned oe = (unsigned)(row * D + pn * BM + cseg);
#pragma unroll
        for (int bj = 0; bj < 2; ++bj) {
            if (NV == 2) { buf[bj] = __builtin_bit_cast(f32x4, ldg<u32x4>(xbin, (oe + bj * HALF) * 2u)); buf[2 + bj] = __builtin_bit_cast(f32x4, ldg<u32x4>(emb, (oe + bj * HALF) * 2u)); }
            else { const u32x2 x2 = ldg<u32x2>(xbin, (oe + bj * HALF) * 2u), e2 = ldg<u32x2>(emb, (oe + bj * HALF) * 2u);
                buf[bj] = __builtin_bit_cast(f32x4, (u32x4){x2.x, x2.y, 0u, 0u}); buf[2 + bj] = __builtin_bit_cast(f32x4, (u32x4){e2.x, e2.y, 0u, 0u}); } }
    }
    template <int NV> __device__ __forceinline__ void seg(int row, int cseg, int pn, const f32x4* v0, const f32x4* v1, float rs, bool, const f32x4* buf) const {
        const unsigned oe = (unsigned)(row * D + pn * BM + cseg);
        float ss = 0.f;
#pragma unroll
        for (int bj = 0; bj < 2; ++bj) { const f32x4* v = bj ? v1 : v0; f32x4 r[NV], e[2], x[2];
            const u32x4 xw = __builtin_bit_cast(u32x4, buf[bj]), ew = __builtin_bit_cast(u32x4, buf[2 + bj]);
            x[0] = (f32x4){bflo(xw.x), bfhi(xw.x), bflo(xw.y), bfhi(xw.y)}; x[1] = (f32x4){bflo(xw.z), bfhi(xw.z), bflo(xw.w), bfhi(xw.w)};
            e[0] = (f32x4){bflo(ew.x), bfhi(ew.x), bflo(ew.y), bfhi(ew.y)}; e[1] = (f32x4){bflo(ew.z), bfhi(ew.z), bflo(ew.w), bfhi(ew.w)};
#pragma unroll
            for (int n = 0; n < NV; ++n) { const f32x4 a = v[n] * rs;
#pragma unroll
                for (int k = 0; k < 4; ++k) r[n][k] = x[n][k] + sigmoid_f(a[k]) * e[n][k]; }
            stg(xb, (oe + bj * HALF) * 2u, PackT<NV>::pack(r)); ss += sumsq<NV>(r); }
        ss += __shfl_xor(ss, 16); ss += __shfl_xor(ss, 32);
        if ((__builtin_amdgcn_mbcnt_hi(~0u, __builtin_amdgcn_mbcnt_lo(~0u, 0u)) >> 4) == 0u) unsafeAtomicAdd(ssq_out + row, ss);
    }
};

struct EpiPleFin {
    static constexpr bool FIN = true;
    const bf16* xin; const bf16* emb; const float* ssq_in; float* ssq_out; const float* gfin; float* out; unsigned* pcnt; unsigned* tmo;
    template <int NV> __device__ __forceinline__ float row(int row, int cseg, int pn, f32x4* v0, f32x4* v1, float rs) const {
        const unsigned oe = (unsigned)(row * D + pn * BM + cseg);
        f32x4 xb_[2][NV]; typename PackT<NV>::T eb[2], xw[2];
#pragma unroll
        for (int bj = 0; bj < 2; ++bj) { eb[bj] = ldg<typename PackT<NV>::T>(emb, (oe + bj * HALF) * 2u); xw[bj] = ldg<typename PackT<NV>::T>(xin, (oe + bj * HALF) * 2u); }
#pragma unroll
        for (int bj = 0; bj < 2; ++bj) PackT<NV>::unpack(xw[bj], xb_[bj]);
        float ss = 0.f;
#pragma unroll
        for (int bj = 0; bj < 2; ++bj) { f32x4* v = bj ? v1 : v0; f32x4 e[NV]; PackT<NV>::unpack(eb[bj], e);
#pragma unroll
            for (int n = 0; n < NV; ++n) { const f32x4 a = v[n] * rs; f32x4 r;
#pragma unroll
                for (int k = 0; k < 4; ++k) r[k] = xb_[bj][n][k] + sigmoid_f(a[k]) * e[n][k];
                v[n] = r; ss += (r[0] * r[0] + r[1] * r[1]) + (r[2] * r[2] + r[3] * r[3]); } }
        ss += __shfl_xor(ss, 16); ss += __shfl_xor(ss, 32);
        return ss;
    }
    __device__ __forceinline__ void tile(Acc& acc, const Unit& u, int wr, int wc, int fr, int fq) const {
        const int row0 = u.pm * BM + wr * 64 + fr, cseg = wc * 32 + 8 * fq;
        float rsv[2][4];
#pragma unroll
        for (int ai = 0; ai < 2; ++ai)
#pragma unroll
            for (int m = 0; m < 4; ++m) rsv[ai][m] = ldg<float>(ssq_in, (unsigned)(row0 + ai * HALF + m * 16) * 4u);
#pragma unroll
        for (int ai = 0; ai < 2; ++ai)
#pragma unroll
            for (int m = 0; m < 4; ++m) { const int r_ = row0 + ai * HALF + m * 16;
                const float ss = row<2>(r_, cseg, u.pn, acc[ai][0][m], acc[ai][1][m], __builtin_amdgcn_rsqf(rsv[ai][m] * (1.f / D) + EPS));
                if (fq == 0) unsafeAtomicAdd(ssq_out + r_, ss); }
    }
    __device__ __forceinline__ void strip(f32x4 (&accx)[2], const Unit& u, int wr, int wc, int fr, int fq) const {
        const int r_ = MP + 16 * u.pm + fr, cseg = wc * 32 + 8 * fq + 4 * wr;
        const float ss = row<1>(r_, cseg, u.pn, &accx[0], &accx[1], __builtin_amdgcn_rsqf(ldg<float>(ssq_in, (unsigned)r_ * 4u) * (1.f / D) + EPS));
        if (fq == 0) unsafeAtomicAdd(ssq_out + r_, ss);
    }
    __device__ __forceinline__ void finish(Acc& acc, f32x4 (&accx)[2], const Unit& u, int wr, int wc, int fr, int fq, int wid) const {
        asm volatile("s_waitcnt vmcnt(0)\n\ts_barrier" ::: "memory");
        if (wid == 0 && fr == 0 && fq == 0) {
            unsigned* c = pcnt + 64 * u.pm;
            __hip_atomic_fetch_add(c, 1u, __ATOMIC_RELAXED, __HIP_MEMORY_SCOPE_AGENT);
            unsigned sp = 0u;
            while (__hip_atomic_load(c, __ATOMIC_RELAXED, __HIP_MEMORY_SCOPE_AGENT) < 8u) { __builtin_amdgcn_s_sleep(1);
                if (++sp > (1u << 22)) { __hip_atomic_store(tmo, 0x900u | (unsigned)u.pm, __ATOMIC_RELAXED, __HIP_MEMORY_SCOPE_AGENT); break; } }
        }
        asm volatile("s_waitcnt vmcnt(0) lgkmcnt(0)\n\ts_barrier" ::: "memory");
        const int row0 = u.pm * BM + wr * 64 + fr, cseg = wc * 32 + 8 * fq;
        float sq[2][4];
#pragma unroll
        for (int ai = 0; ai < 2; ++ai)
#pragma unroll
            for (int m = 0; m < 4; ++m) sq[ai][m] = __builtin_bit_cast(float, __hip_atomic_load((const unsigned*)(ssq_out + row0 + ai * HALF + m * 16), __ATOMIC_RELAXED, __HIP_MEMORY_SCOPE_AGENT));
        const int rx = MP + 16 * u.pm + fr;
        const float sqx = __builtin_bit_cast(float, __hip_atomic_load((const unsigned*)(ssq_out + rx), __ATOMIC_RELAXED, __HIP_MEMORY_SCOPE_AGENT));
        f32x4 g4[2][2];
#pragma unroll
        for (int bj = 0; bj < 2; ++bj)
#pragma unroll
            for (int n = 0; n < 2; ++n) g4[bj][n] = ldg<f32x4>(gfin, (unsigned)(u.pn * BM + bj * HALF + cseg + 4 * n) * 4u);
#pragma unroll
        for (int ai = 0; ai < 2; ++ai)
#pragma unroll
            for (int m = 0; m < 4; ++m) { const float rs = __builtin_amdgcn_rsqf(sq[ai][m] * (1.f / D) + EPS); const unsigned oe = (unsigned)((row0 + ai * HALF + m * 16) * D + u.pn * BM + cseg);
#pragma unroll
                for (int bj = 0; bj < 2; ++bj)
#pragma unroll
                    for (int n = 0; n < 2; ++n) stg(out, (oe + bj * HALF + 4 * n) * 4u, acc[ai][bj][m][n] * rs * g4[bj][n]); }
        { const float rs = __builtin_amdgcn_rsqf(sqx * (1.f / D) + EPS); const unsigned oe = (unsigned)(rx * D + u.pn * BM + cseg + 4 * wr);
#pragma unroll
          for (int bj = 0; bj < 2; ++bj) stg(out, (oe + bj * HALF) * 4u, accx[bj] * rs * g4[bj][wr]); }
    }
};

struct EpiRetIn {
    static constexpr bool RSTD = true; static constexpr int PRE = 0, PB = 1;
    bf16* P; const float* ssq_in; const float* rope;
    template <int NV> __device__ __forceinline__ void seg(int row, int cseg, int pn, const f32x4* v0, const f32x4* v1, float rs, bool smp, const f32x4*) const {
        const int kind = pn < 8 ? 0 : (pn < 16 ? 1 : (pn < 32 ? 2 : 3));
        const unsigned pb = (unsigned)(row * NPROJ + pn * BM + cseg) * 2u;
        f32x4 o1[NV], o2[NV];
        if (kind <= 1) {
            const int pi = smp ? SEQ + ((row - MP) & 3) : (row & (SEQ - 1));
            float sc = rs;
            if (kind == 1) sc *= 0.0625f * (smp ? 1.f : __builtin_amdgcn_exp2f(-(float)((row & 127) + 1) * gamma_l2(pn - 8)));
#pragma unroll
            for (int n = 0; n < NV; ++n) { const f32x4 c = ldg<f32x4>(rope, (unsigned)(pi * 128 + cseg + 4 * n) * 4u), s_ = ldg<f32x4>(rope, (unsigned)((NPOS + pi) * 128 + cseg + 4 * n) * 4u);
                const f32x4 x1 = v0[n] * sc, x2 = v1[n] * sc;
                o1[n] = x1 * c - x2 * s_; o2[n] = x1 * s_ + x2 * c; }
        } else {
#pragma unroll
            for (int n = 0; n < NV; ++n) { o1[n] = v0[n] * rs; o2[n] = v1[n] * rs;
                if (kind == 3) {
#pragma unroll
                    for (int k = 0; k < 4; ++k) { o1[n][k] = silu_f(o1[n][k]); o2[n][k] = silu_f(o2[n][k]); } } }
        }
        stg(P, pb, PackT<NV>::pack(o1)); stg(P, pb + HALF * 2, PackT<NV>::pack(o2));
    }
};

struct EpiRetIn2 {
    static constexpr bool FIN = true;
    bf16* P; const float* ssq_in; const float* rope;
    __device__ __forceinline__ void tile(const Acc&, const Unit&, int, int, int, int) const {}
    __device__ __forceinline__ void strip(const f32x4 (&)[2], const Unit&, int, int, int, int) const {}
    __device__ __forceinline__ void finish(Acc& acc, f32x4 (&accx)[2], const Unit& u, int wr, int wc, int fr, int fq, int) const {
        const int pn = u.pn, kind = pn < 8 ? 0 : (pn < 16 ? 1 : (pn < 32 ? 2 : 3));
        const int row0 = u.pm * BM + wr * 64 + fr, cseg = wc * 32 + 8 * fq, xrow = MP + 16 * u.pm + fr, xseg = cseg + 4 * wr;
        float rsv[2][4];
#pragma unroll
        for (int ai = 0; ai < 2; ++ai)
#pragma unroll
            for (int m = 0; m < 4; ++m) rsv[ai][m] = ldg<float>(ssq_in, (unsigned)(row0 + ai * HALF + m * 16) * 4u);
        const float rsx = ldg<float>(ssq_in, (unsigned)xrow * 4u);
        const unsigned xb_ = (unsigned)(xrow * NPROJ + pn * BM + xseg) * 2u;
        if (kind <= 1) {
            f32x4 c[2][2], s_[2][2], dc[2], ds[2];
#pragma unroll
            for (int ai = 0; ai < 2; ++ai) { const int pi = (row0 + ai * HALF) & (SEQ - 1);
#pragma unroll
                for (int n = 0; n < 2; ++n) { c[ai][n] = ldg<f32x4>(rope, (unsigned)(pi * 128 + cseg + 4 * n) * 4u); s_[ai][n] = ldg<f32x4>(rope, (unsigned)((NPOS + pi) * 128 + cseg + 4 * n) * 4u); } }
#pragma unroll
            for (int n = 0; n < 2; ++n) { dc[n] = ldg<f32x4>(rope, (unsigned)(16 * 128 + cseg + 4 * n) * 4u); ds[n] = ldg<f32x4>(rope, (unsigned)((NPOS + 16) * 128 + cseg + 4 * n) * 4u); }
            const int pix = SEQ + ((xrow - MP) & 3);
            const f32x4 cx = ldg<f32x4>(rope, (unsigned)(pix * 128 + xseg) * 4u), sx = ldg<f32x4>(rope, (unsigned)((NPOS + pix) * 128 + xseg) * 4u);
            const float l2g = (kind == 1) ? gamma_l2(pn - 8) : 0.f, ksc = (kind == 1) ? 0.0625f : 1.f;
#pragma unroll
            for (int ai = 0; ai < 2; ++ai)
#pragma unroll
                for (int m = 0; m < 4; ++m) { const int row = row0 + ai * HALF + m * 16;
                    const float sc = __builtin_amdgcn_rsqf(rsv[ai][m] * (1.f / D) + EPS) * ksc * __builtin_amdgcn_exp2f(-(float)((row & 127) + 1) * l2g);
                    f32x4 o1[2], o2[2];
#pragma unroll
                    for (int n = 0; n < 2; ++n) { const f32x4 x1 = acc[ai][0][m][n] * sc, x2 = acc[ai][1][m][n] * sc; o1[n] = x1 * c[ai][n] - x2 * s_[ai][n]; o2[n] = x1 * s_[ai][n] + x2 * c[ai][n]; }
                    const unsigned pb = (unsigned)(row * NPROJ + pn * BM + cseg) * 2u;
                    stg(P, pb, PackT<2>::pack(o1)); stg(P, pb + HALF * 2, PackT<2>::pack(o2));
                    if (m < 3) {
#pragma unroll
                        for (int n = 0; n < 2; ++n) { const f32x4 cn = c[ai][n] * dc[n] - s_[ai][n] * ds[n], sn = s_[ai][n] * dc[n] + c[ai][n] * ds[n]; c[ai][n] = cn; s_[ai][n] = sn; } } }
            { const float sc = __builtin_amdgcn_rsqf(rsx * (1.f / D) + EPS) * ksc; const f32x4 x1 = accx[0] * sc, x2 = accx[1] * sc;
              const f32x4 o1 = x1 * cx - x2 * sx, o2 = x1 * sx + x2 * cx;
              stg(P, xb_, PackT<1>::pack(&o1)); stg(P, xb_ + HALF * 2, PackT<1>::pack(&o2)); }
        } else {
#pragma unroll
            for (int ai = 0; ai < 2; ++ai)
#pragma unroll
                for (int m = 0; m < 4; ++m) { const int row = row0 + ai * HALF + m * 16; const float rs = __builtin_amdgcn_rsqf(rsv[ai][m] * (1.f / D) + EPS);
                    f32x4 o1[2], o2[2];
#pragma unroll
                    for (int n = 0; n < 2; ++n) { o1[n] = acc[ai][0][m][n] * rs; o2[n] = acc[ai][1][m][n] * rs;
                        if (kind == 3) {
#pragma unroll
                            for (int k = 0; k < 4; ++k) { o1[n][k] = silu_f(o1[n][k]); o2[n][k] = silu_f(o2[n][k]); } } }
                    const unsigned pb = (unsigned)(row * NPROJ + pn * BM + cseg) * 2u;
                    stg(P, pb, PackT<2>::pack(o1)); stg(P, pb + HALF * 2, PackT<2>::pack(o2)); }
            { const float rs = __builtin_amdgcn_rsqf(rsx * (1.f / D) + EPS); f32x4 o1 = accx[0] * rs, o2 = accx[1] * rs;
              if (kind == 3) {
#pragma unroll
                  for (int k = 0; k < 4; ++k) { o1[k] = silu_f(o1[k]); o2[k] = silu_f(o2[k]); } }
              stg(P, xb_, PackT<1>::pack(&o1)); stg(P, xb_ + HALF * 2, PackT<1>::pack(&o2)); }
        }
    }
};

#ifndef ROT_DPP
#define ROT_DPP 1
#endif
#if ROT_DPP
__device__ __forceinline__ float rot1(float x, int) { return __int_as_float(__builtin_amdgcn_update_dpp(0, __float_as_int(x), 0x121  , 0xf, 0xf, false)); }
#else
__device__ __forceinline__ float rot1(float x, int addr) { return __int_as_float(__builtin_amdgcn_ds_bpermute(addr, __float_as_int(x))); }
#endif
__device__ __forceinline__ f32x4 rot4(f32x4 v, int addr) { f32x4 r; r.x = rot1(v.x, addr); r.y = rot1(v.y, addr); r.z = rot1(v.z, addr); r.w = rot1(v.w, addr); return r; }
__device__ __forceinline__ f32x4 sel4(bool c, f32x4 a, f32x4 b) { return (f32x4){c ? a[0] : b[0], c ? a[1] : b[1], c ? a[2] : b[2], c ? a[3] : b[3]}; }
struct EpiUpAct {
    static constexpr bool FIN = false;
    bf16* ACT; const float* ssq_in; float* convP; float* convS; const float* cw; const float* cb; const float* sconv; float* ubnd; LAS float* xch;
    __device__ __forceinline__ void tile(Acc& acc, const Unit& u, int wr, int wc, int fr, int fq) const {
        const int row0 = u.pm * BM + wr * 64 + fr, cseg = wc * 32 + 8 * fq; const bool smp = u.pm >= MP / BM;
        { float rsv[2][4];
#pragma unroll
          for (int ai = 0; ai < 2; ++ai)
#pragma unroll
            for (int m = 0; m < 4; ++m) rsv[ai][m] = ldg<float>(ssq_in, (unsigned)(row0 + ai * HALF + m * 16) * 4u);
#pragma unroll
          for (int ai = 0; ai < 2; ++ai)
#pragma unroll
            for (int m = 0; m < 4; ++m) { const float rs = __builtin_amdgcn_rsqf(rsv[ai][m] * (1.f / D) + EPS);
#pragma unroll
                for (int bj = 0; bj < 2; ++bj)
#pragma unroll
                    for (int n = 0; n < 2; ++n) acc[ai][bj][m][n] = acc[ai][bj][m][n] * rs; } }
        { float* cbase = smp ? convS : convP;
#pragma unroll
          for (int ai = 0; ai < 2; ++ai)
#pragma unroll
            for (int m = 0; m < 4; ++m) { const int row = row0 + ai * HALF + m * 16; int crow = -1;
                if (!smp) { const int t = row & (SEQ - 1); if (t >= SEQ - 2) crow = (row >> 11) * 2 + (t - (SEQ - 2)); }
                else { const int s_ = row - MP, t = s_ & 3; if (t >= 2) crow = (s_ >> 2) * 2 + (t - 2); }
                if (crow >= 0) {
#pragma unroll
                    for (int bj = 0; bj < 2; ++bj)
#pragma unroll
                        for (int n = 0; n < 2; ++n) stg(cbase, (unsigned)(crow * F2 + bj * FF + u.pn * HALF + cseg + 4 * n) * 4u, acc[ai][bj][m][n]); } } }
        if (fr >= 14) {
#pragma unroll
            for (int ai = 0; ai < 2; ++ai)
#pragma unroll
                for (int bj = 0; bj < 2; ++bj)
#pragma unroll
                    for (int n = 0; n < 2; ++n) *(LAS f32x4*)(xch + ((ai * 2 + wr) * 2 + (fr - 14)) * 256 + bj * HALF + cseg + 4 * n) = acc[ai][bj][3][n]; }
        if (!smp) {
            if (wr == 0 && fr < 2) {
#pragma unroll
                for (int bj = 0; bj < 2; ++bj)
#pragma unroll
                    for (int n = 0; n < 2; ++n) stg(ubnd, (unsigned)((u.pm * 4 + fr) * F2 + u.pn * BM + bj * HALF + cseg + 4 * n) * 4u, acc[0][bj][0][n]); }
            if (wr == 1 && fr >= 14) {
#pragma unroll
                for (int bj = 0; bj < 2; ++bj)
#pragma unroll
                    for (int n = 0; n < 2; ++n) stg(ubnd, (unsigned)((u.pm * 4 + 2 + (fr - 14)) * F2 + u.pn * BM + bj * HALF + cseg + 4 * n) * 4u, acc[1][bj][3][n]); }
        }
        asm volatile("s_waitcnt lgkmcnt(0)\n\ts_barrier" ::: "memory");
        const int lane = fq * 16 + fr, baddr = ((lane & 48) | ((fr - 1) & 15)) * 4;
        const bool f1 = fr >= 1, t1 = (fr & 3) >= 1;
#pragma unroll
        for (int n = 0; n < 2; ++n) {
            const int f4 = u.pn * HALF + cseg + 4 * n;
            f32x4 wg[3], wu[3];
#pragma unroll
            for (int j = 0; j < 3; ++j) { wg[j] = ldg<f32x4>(cw, (unsigned)(j * F2 + f4) * 4u); wu[j] = ldg<f32x4>(cw, (unsigned)(j * F2 + FF + f4) * 4u); }
            const f32x4 bg = ldg<f32x4>(cb, (unsigned)f4 * 4u), bu = ldg<f32x4>(cb, (unsigned)(FF + f4) * 4u);
            f32x4 rgp = (f32x4){0.f, 0.f, 0.f, 0.f}, rup = rgp, r1gp = rgp, r1up = rgp;
#pragma unroll
            for (int ai = 0; ai < 2; ++ai)
#pragma unroll
                for (int m = 0; m < 4; ++m) {
                    const int row = row0 + ai * HALF + m * 16;
                    const f32x4 cg = acc[ai][0][m][n], cu = acc[ai][1][m][n];
                    const f32x4 rg = rot4(cg, baddr), ru = rot4(cu, baddr);
                    f32x4 p1g, p1u, p2g, p2u;
                    if (!smp) {
                        if (m == 0) {
                            f32x4 x0g = (f32x4){0.f, 0.f, 0.f, 0.f}, x1g = x0g, x0u = x0g, x1u = x0g;
                            const int bi = ai * 2 + wr;
                            if (bi > 0) { const LAS float* xp = xch + ((bi - 1) * 2) * 256 + cseg + 4 * n;
                                x0g = *(const LAS f32x4*)xp; x1g = *(const LAS f32x4*)(xp + 256); x0u = *(const LAS f32x4*)(xp + HALF); x1u = *(const LAS f32x4*)(xp + 256 + HALF); }
                            p1g = sel4(f1, rg, x1g); p1u = sel4(f1, ru, x1u);
                            const f32x4 r1g = rot4(p1g, baddr), r1u = rot4(p1u, baddr);
                            p2g = sel4(f1, r1g, x0g); p2u = sel4(f1, r1u, x0u); r1gp = r1g; r1up = r1u;
                        } else {
                            p1g = sel4(f1, rg, rgp); p1u = sel4(f1, ru, rup);
                            const f32x4 r1g = rot4(p1g, baddr), r1u = rot4(p1u, baddr);
                            p2g = sel4(f1, r1g, r1gp); p2u = sel4(f1, r1u, r1up); r1gp = r1g; r1up = r1u;
                        }
                    } else {
                        const unsigned so = (unsigned)(((row - MP) >> 2) * 2 * F2 + f4) * 4u;
                        const f32x4 s0g = ldg<f32x4>(sconv, so), s1g = ldg<f32x4>(sconv, so + F2 * 4u), s0u = ldg<f32x4>(sconv, so + FF * 4u), s1u = ldg<f32x4>(sconv, so + (F2 + FF) * 4u);
                        p1g = sel4(t1, rg, s1g); p1u = sel4(t1, ru, s1u);
                        const f32x4 r1g = rot4(p1g, baddr), r1u = rot4(p1u, baddr);
                        p2g = sel4(t1, r1g, s0g); p2u = sel4(t1, r1u, s0u);
                    }
                    rgp = rg; rup = ru;
                    const f32x4 gg = wg[0] * p2g + wg[1] * p1g + wg[2] * cg + bg, uu = wu[0] * p2u + wu[1] * p1u + wu[2] * cu + bu;
                    u32x2 w; w.x = pk2(silu_f(gg[0]) * uu[0], silu_f(gg[1]) * uu[1]); w.y = pk2(silu_f(gg[2]) * uu[2], silu_f(gg[3]) * uu[3]);
                    stg(ACT, (unsigned)(row * FF + f4) * 2u, w);
                }
        }
    }
    __device__ __forceinline__ void strip(const f32x4 (&)[2], const Unit&, int, int, int, int) const {}
};
}

#define XB_TMO      128
#define XB_XCNT(j)  (256  + 64 * (j))
#define XB_XSUB(j)  (1280 + 64 * (j))
#define XB_XGEN(j)  (2304 + 64 * (j))
#define XB_TOP      3328
#define XB_TOPGEN   3392
#define XCD_BAR_WORDS 3456
#define XB_SPIN_CAP (1u << 22)
__device__ __forceinline__ unsigned xb_ld(unsigned* p)              { return __hip_atomic_load(p, __ATOMIC_RELAXED, __HIP_MEMORY_SCOPE_AGENT); }
__device__ __forceinline__ unsigned xb_add(unsigned* p, unsigned v) { return __hip_atomic_fetch_add(p, v, __ATOMIC_RELAXED, __HIP_MEMORY_SCOPE_AGENT); }
__device__ __forceinline__ unsigned xb_xcc_id() { return (unsigned)__builtin_amdgcn_s_getreg((3 << 11) | 20) & 0xFu; }
#define XB_SPIN(cond, bar) do { unsigned _sp = 0; while (cond) { __builtin_amdgcn_s_sleep(1); \
    if ((++_sp & 255u) == 0u) { if (xb_ld(&(bar)[XB_TMO])) break; if (_sp > XB_SPIN_CAP) { atomicAdd(&(bar)[XB_TMO], 1u); break; } } } } while (0)
struct XcdBarrier { unsigned* bar; unsigned x; volatile LAS unsigned* st; };
__device__ __forceinline__ XcdBarrier xcd_barrier_post(unsigned* bar, volatile LAS unsigned* st) {
    XcdBarrier b; b.bar = bar; b.x = xb_xcc_id(); b.st = st;
    if (threadIdx.x == 0) (void)xb_add(&bar[XB_XCNT(b.x)], 1u);
    return b;
}
__device__ __forceinline__ void xcd_barrier_complete(unsigned* bar, unsigned x, unsigned& nloc, unsigned& nx) {
    const unsigned G = gridDim.x * gridDim.y * gridDim.z;
    unsigned sum, cnt, mine, sp = 0u;
    for (;;) {
        sum = 0u; cnt = 0u; mine = 0u;
#pragma unroll
        for (unsigned j = 0; j < 16; ++j) { const unsigned c = xb_ld(&bar[XB_XCNT(j)]); sum += c; cnt += (c > 0u) ? 1u : 0u; mine = (j == x) ? c : mine; }
        if (sum == G) break;
        __builtin_amdgcn_s_sleep(1);
        if ((++sp & 255u) == 0u) { if (xb_ld(&bar[XB_TMO])) break; if (sp > XB_SPIN_CAP) { atomicAdd(&bar[XB_TMO], 1u); break; } }
    }
    nloc = mine > 0u ? mine : 1u; nx = cnt > 0u ? cnt : 1u;
}
__device__ __forceinline__ void xcd_barrier(const XcdBarrier& b, int wave_s) {
    asm volatile("s_waitcnt vmcnt(0)" ::: "memory");
    __syncthreads();
    if (wave_s == 0 && __builtin_amdgcn_mbcnt_hi(~0u, __builtin_amdgcn_mbcnt_lo(~0u, 0u)) == 0u) {
        unsigned* bar = b.bar;
        __builtin_amdgcn_s_waitcnt(0);
        unsigned nloc = b.st[0], nx = b.st[1];
        if (nloc == 0u) { xcd_barrier_complete(bar, b.x, nloc, nx); b.st[0] = nloc; b.st[1] = nx; }
        const unsigned old = xb_add(&bar[XB_XSUB(b.x)], 1u);
        const unsigned gen = old / nloc;
        if (old + 1u == (gen + 1u) * nloc) {
            __builtin_amdgcn_fence(__ATOMIC_RELEASE, "agent");
            asm volatile("s_waitcnt vmcnt(0)" ::: "memory");
            const unsigned og = xb_add(&bar[XB_TOP], 1u);
            const unsigned tg = og / nx;
            if (og + 1u == (tg + 1u) * nx) xb_add(&bar[XB_TOPGEN], 1u);
            else XB_SPIN(xb_ld(&bar[XB_TOPGEN]) == tg, bar);
            __builtin_amdgcn_fence(__ATOMIC_ACQUIRE, "agent");
            xb_add(&bar[XB_XGEN(b.x)], 1u);
            asm volatile("s_waitcnt vmcnt(0)" ::: "memory");
        } else {
            XB_SPIN(xb_ld(&bar[XB_XGEN(b.x)]) == gen, bar);
            __builtin_amdgcn_fence(__ATOMIC_ACQUIRE, "agent");
            asm volatile("s_waitcnt vmcnt(0)" ::: "memory");
        }
    }
    __syncthreads();
}

struct Args { const float* in[21]; float* out; unsigned char* ws; int ph_lo, ph_hi; };
static_assert(sizeof(Args) == 21 * 8 + 8 + 8 + 8, "Args has no padding");

struct TItem { const float* W; bf16* WT; const float* gain; int K, N, row_off, mode, item; };
__device__ __forceinline__ void p0_tr_load(const TItem& t, f32x4 (&v)[8], float (&gv)[8], int lane) {
    const int nblk = t.N / 32, kb = t.item / nblk, nb = t.item % nblk, k0 = 64 * kb, n0 = 32 * nb, kr = lane >> 3, nq = lane & 7;
#pragma unroll
    for (int i = 0; i < 8; ++i) v[i] = __builtin_nontemporal_load((const f32x4*)(t.W + (size_t)(k0 + 8 * i + kr) * t.N + n0 + 4 * nq));
#pragma unroll
    for (int i = 0; i < 8; ++i) gv[i] = t.gain ? t.gain[k0 + 8 * i + kr] : 1.f;
}
__device__ __forceinline__ void p0_tr_store(const TItem& t, const f32x4 (&v)[8], const float (&gv)[8], LAS float* scr, int lane) {
    const int nblk = t.N / 32, kb = t.item / nblk, nb = t.item % nblk, k0 = 64 * kb, n0 = 32 * nb, kr = lane >> 3, nq = lane & 7;
#pragma unroll
    for (int i = 0; i < 8; ++i) { const int kk = 8 * i + kr; const f32x4 w = v[i] * gv[i];
        LAS float* d = scr + kk * 33 + 4 * nq; d[0] = w[0]; d[1] = w[1]; d[2] = w[2]; d[3] = w[3]; }
    asm volatile("s_waitcnt lgkmcnt(0)" ::: "memory");
    int drow0 = t.row_off + n0;
    if (t.mode == 1) drow0 = (n0 < FF) ? 256 * (n0 >> 7) + (n0 & 127) : 256 * ((n0 - FF) >> 7) + 128 + ((n0 - FF) & 127);
    const int c = lane & 7;
#pragma unroll
    for (int j = 0; j < 4; ++j) { const int n = (lane >> 3) + 8 * j; const LAS float* s_ = scr + (8 * c) * 33 + n;
        u32x4 o; o.x = pk2(s_[0 * 33], s_[1 * 33]); o.y = pk2(s_[2 * 33], s_[3 * 33]); o.z = pk2(s_[4 * 33], s_[5 * 33]); o.w = pk2(s_[6 * 33], s_[7 * 33]);
        *(u32x4*)(t.WT + (size_t)(drow0 + n) * t.K + k0 + 8 * c) = o; }
    asm volatile("s_waitcnt lgkmcnt(0)" ::: "memory");
}

__device__ __forceinline__ void sincos_d(double a, double& s, double& c) {
    const double kq = __builtin_rint(a * 0.63661977236758134308);
    double r = __builtin_fma(-kq, 1.57079632679489655800e+00, a); r = __builtin_fma(-kq, 6.12323399573676603587e-17, r);
    const int q = (int)((long long)kq & 3);
    const double r2 = r * r;
    const double sp = r * (1.0 + r2 * (-1.0 / 6 + r2 * (1.0 / 120 + r2 * (-1.0 / 5040 + r2 * (1.0 / 362880 + r2 * (-1.0 / 39916800 + r2 * (1.0 / 6227020800.0)))))));
    const double cp = 1.0 + r2 * (-0.5 + r2 * (1.0 / 24 + r2 * (-1.0 / 720 + r2 * (1.0 / 40320 + r2 * (-1.0 / 3628800 + r2 * (1.0 / 479001600 + r2 * (-1.0 / 87178291200.0)))))));
    s = (q == 0) ? sp : (q == 1) ? cp : (q == 2) ? -sp : -cp;
    c = (q == 0) ? cp : (q == 1) ? -sp : (q == 2) ? -cp : sp;
}

__device__ __forceinline__ void p0_pool_item(const Args& a, LAS unsigned char* lds, int item, int tid, int wave, int lane) {
    LAS float* rs = (LAS float*)lds;
    const bool prompt = item < 256;
    const float* xbase; int nrows, nhalo, b, t0;
    if (prompt) { b = item >> 6; t0 = (item & 63) * 32; xbase = a.in[0] + (size_t)b * SEQ * D; nrows = 47; nhalo = 15; }
    else { b = item - 256; t0 = 0; xbase = a.in[1] + (size_t)b * DS * D; nrows = 19; nhalo = 15; }
    for (int e0 = wave; e0 < nrows; e0 += 2 * NWAVES) {
        f32x4 xv[2][8]; float r[2] = {0.f, 0.f};
#pragma unroll
        for (int h = 0; h < 2; ++h) { const int e = e0 + h * NWAVES, t = t0 - nhalo + e;
            if (e < nrows && t >= 0) { const f32x4* xr = (const f32x4*)(xbase + (size_t)t * D) + lane;
#pragma unroll
                for (int j = 0; j < 8; ++j) xv[h][j] = xr[64 * j]; } }
#pragma unroll
        for (int h = 0; h < 2; ++h) { const int e = e0 + h * NWAVES, t = t0 - nhalo + e;
            if (e < nrows) {
                if (t >= 0) { float s_ = 0.f;
#pragma unroll
                    for (int j = 0; j < 8; ++j) { const f32x4 v = xv[h][j]; s_ += (v.x * v.x + v.y * v.y) + (v.z * v.z + v.w * v.w); }
                    r[h] = __builtin_amdgcn_rsqf(wave_sum(s_) * (1.f / D) + EPS); }
                if (lane == 0) rs[e] = r[h]; } }
    }
    __syncthreads();
    const int c0 = 4 * tid, win = 2 << (tid >> 7);
    const f32x4 g4 = *(const f32x4*)(a.in[7] + c0);
    bf16* DPRE = (bf16*)(a.ws + WS_DPRE);
    f32x4 w[16];
#pragma unroll
    for (int j = 0; j < 16; ++j) w[j] = (f32x4){0.f, 0.f, 0.f, 0.f};
    for (int e0 = 0; e0 < nrows; e0 += 8) {
        f32x4 xv[8];
#pragma unroll
        for (int i = 0; i < 8; ++i) { const int e = e0 + i, t = t0 - nhalo + e;
            xv[i] = (f32x4){0.f, 0.f, 0.f, 0.f};
            if (e < nrows) {
                if (prompt) { if (t >= 0) xv[i] = *(const f32x4*)(xbase + (size_t)t * D + c0); }
                else { if (e < 15) xv[i] = *(const f32x4*)(a.in[4] + ((size_t)b * PBUF + e) * D + c0); else xv[i] = *(const f32x4*)(xbase + (size_t)t * D + c0); } } }
#pragma unroll
        for (int i = 0; i < 8; ++i) { const int e = e0 + i, t = t0 - nhalo + e;
            if (e < nrows) {
                f32x4 hv = xv[i];
                if (prompt || e >= 15) hv = hv * rs[e] * g4;
#pragma unroll
                for (int j = 15; j > 0; --j) w[j] = w[j - 1];
                w[0] = hv;
                if (e >= nhalo) {
                    f32x4 s4 = (f32x4){0.f, 0.f, 0.f, 0.f};
#pragma unroll
                    for (int j = 0; j < 16; ++j) if (j < win) s4 += w[j];
                    const int cnt = prompt ? ((t + 1 < win) ? t + 1 : win) : win;
                    const f32x4 d = s4 * (1.f / (float)cnt) - hv;
                    const int row = prompt ? b * SEQ + t : MP + b * DS + t;
                    u32x2 o; o.x = pk2(d[0], d[1]); o.y = pk2(d[2], d[3]);
                    *(u32x2*)(DPRE + (size_t)row * D + c0) = o;
                }
                if (prompt) { if (t >= SEQ - PBUF) *(f32x4*)(a.out + O_PP + ((size_t)b * PBUF + (t - (SEQ - PBUF))) * D + c0) = hv; }
                else { if (e >= 4) *(f32x4*)(a.out + O_PS + ((size_t)b * PBUF + (e - 4)) * D + c0) = hv; }
            } }
    }
    __syncthreads();
}

#define LAUNDER_TID() int wave = __builtin_amdgcn_readfirstlane(wave_s); int lane = (int)__builtin_amdgcn_mbcnt_hi(~0u, __builtin_amdgcn_mbcnt_lo(~0u, 0u)); asm volatile("" : "+v"(lane)); int tid = wave * 64 + lane; (void)tid
__device__ __forceinline__ void p0_prologue(const Args& a, LAS unsigned char* lds, int wave_s) {
    LAUNDER_TID();
    const int G = gridDim.x, gw = blockIdx.x * NWAVES + wave, NGW = G * NWAVES;
    unsigned char* ws = a.ws;
    LAS float* scr = (LAS float*)(lds + wave * 16384);
    constexpr int I_POOL = 8 * 16, I_WP = 4 * 64, I_WG = 32 * 64, I_UP = 32 * 352, I_DN = 88 * 64, I_IN = 32 * 384, I_OUT = 64 * 64;
    constexpr int NITEMS = 4 * I_POOL + 2 * I_WP + 2 * I_WG + 2 * I_UP + 2 * I_DN + I_IN + I_OUT;
    auto decode = [&](int it) -> TItem {
        int r = it;
        if (r < 4 * I_POOL) { const int gI = r / I_POOL; return TItem{a.in[11] + (size_t)gI * 512 * 512, (bf16*)(ws + WS_WPOOL), nullptr, 512, 512, gI * 512, 0, r % I_POOL}; } r -= 4 * I_POOL;
        if (r < 2 * I_WP) { const int l = r / I_WP; return TItem{a.in[19] + (size_t)l * PLE * D, (bf16*)(ws + WS_WP) + (size_t)l * D * PLE, nullptr, PLE, D, 0, 0, r % I_WP}; } r -= 2 * I_WP;
        if (r < 2 * I_WG) { const int l = r / I_WG; return TItem{a.in[20] + (size_t)l * D * D, (bf16*)(ws + WS_WG) + (size_t)l * D * D, a.in[9] + l * D, D, D, 0, 0, r % I_WG}; } r -= 2 * I_WG;
        if (r < 2 * I_UP) { const int l = r / I_UP; return TItem{a.in[15] + (size_t)l * D * F2, (bf16*)(ws + WS_WUP) + (size_t)l * F2 * D, a.in[8] + l * D, D, F2, 0, 1, r % I_UP}; } r -= 2 * I_UP;
        if (r < 2 * I_DN) { const int l = r / I_DN; return TItem{a.in[18] + (size_t)l * FF * D, (bf16*)(ws + WS_WDN) + (size_t)l * D * FF, nullptr, FF, D, 0, 0, r % I_DN}; } r -= 2 * I_DN;
        if (r < I_IN) return TItem{a.in[13], (bf16*)(ws + WS_WIN), a.in[7] + D, D, NPROJ, 0, 0, r}; r -= I_IN;
        return TItem{a.in[14], (bf16*)(ws + WS_WOUT), nullptr, 4096, D, 0, 0, r};
    };
    if (gw < NITEMS) {
        TItem cur = decode(gw); f32x4 v[8]; float gv[8];
        p0_tr_load(cur, v, gv, lane);
        for (int it = gw; it < NITEMS; it += NGW) {
            const bool has = it + NGW < NITEMS;
            TItem nxt = cur; f32x4 vn[8]; float gn[8];
            if (has) { nxt = decode(it + NGW); p0_tr_load(nxt, vn, gn, lane); }
            p0_tr_store(cur, v, gv, scr, lane);
            if (has) { cur = nxt;
#pragma unroll
                for (int i = 0; i < 8; ++i) { v[i] = vn[i]; gv[i] = gn[i]; } }
        }
    }
    const int gt = blockIdx.x * NT + tid, NGT = G * NT;
    for (int i = gt; i < 2 * M * PLE / 8; i += NGT) {
        const int e = i * 8, l = e / (M * PLE), rem = e - l * (M * PLE), m = rem / PLE, c = rem % PLE;
        const float* src = (m < MP) ? a.in[2] + ((size_t)l * MP + m) * PLE + c : a.in[3] + ((size_t)l * MS + (m - MP)) * PLE + c;
        const f32x4 v0 = *(const f32x4*)src, v1 = *(const f32x4*)(src + 4);
        { u32x4 w; w.x = pk2(v0[0], v0[1]); w.y = pk2(v0[2], v0[3]); w.z = pk2(v1[0], v1[1]); w.w = pk2(v1[2], v1[3]); *(u32x4*)((bf16*)(ws + WS_PB) + e) = w; }
    }
    float* rope = (float*)(ws + WS_ROPE);
    for (int i = gt; i < NPOS * 128; i += NGT) {
        const int pi = i >> 7, j = i & 127;
        const double pos = (pi < SEQ) ? (double)pi : (double)(PAST + (pi - SEQ));
        const double inv = exp(-(double)j * (9.210340371976182736 / 128.0));
        double s, c; sincos_d(pos * inv, s, c);
        rope[i] = (float)c; rope[NPOS * 128 + i] = (float)s;
    }
    __syncthreads();
    for (int it = blockIdx.x; it < 256 + DB; it += G) p0_pool_item(a, lds, it, tid, wave, lane);
}

__device__ __forceinline__ void act_phase(const Args& a, int layer, int wave_s) {
    LAUNDER_TID();
    const int G = gridDim.x, gw = blockIdx.x * NWAVES + wave, NGW = G * NWAVES;
    const bf16* U = (const bf16*)(a.ws + WS_U); bf16* ACT = (bf16*)(a.ws + WS_ACT);
    const float* cw = a.in[16] + (size_t)layer * 3 * F2; const float* cb = a.in[17] + (size_t)layer * F2;
    const float* sconv = a.in[6] + (size_t)layer * DB * 2 * F2;
    constexpr int NRR = M / 32, NCB = FF / 512;
    for (int it = gw; it < NRR * NCB; it += NGW) {
        const int rr = it / NCB, cbk = it % NCB, m0 = rr * 32, f0 = cbk * 512 + lane * 8;
        const int ug = 256 * (f0 >> 7) + (f0 & 127), uu = ug + 128;
        float wg[3][8], wu[3][8], bg[8], bu[8];
#pragma unroll
        for (int j = 0; j < 3; ++j)
#pragma unroll
            for (int h = 0; h < 2; ++h) { const f32x4 vg = *(const f32x4*)(cw + (size_t)j * F2 + f0 + 4 * h), vu = *(const f32x4*)(cw + (size_t)j * F2 + FF + f0 + 4 * h);
#pragma unroll
                for (int e = 0; e < 4; ++e) { wg[j][4 * h + e] = vg[e]; wu[j][4 * h + e] = vu[e]; } }
#pragma unroll
        for (int h = 0; h < 2; ++h) { const f32x4 vg = *(const f32x4*)(cb + f0 + 4 * h), vu = *(const f32x4*)(cb + FF + f0 + 4 * h);
#pragma unroll
            for (int e = 0; e < 4; ++e) { bg[4 * h + e] = vg[e]; bu[4 * h + e] = vu[e]; } }
        float p1g[8], p2g[8], p1u[8], p2u[8];
        for (int r = 0; r < 32; ++r) {
            const int m = m0 + r; const bool prompt = m < MP; const int t = prompt ? (m & (SEQ - 1)) : ((m - MP) & 3);
            if (r == 0 || t == 0) {
#pragma unroll
                for (int back = 2; back >= 1; --back) {
                    float tg[8], tu[8]; const int tt = t - back;
                    if (tt >= 0) { const u32x4 vg = *(const u32x4*)(U + (size_t)(m - back) * F2 + ug), vu = *(const u32x4*)(U + (size_t)(m - back) * F2 + uu);
                        tg[0] = bflo(vg.x); tg[1] = bfhi(vg.x); tg[2] = bflo(vg.y); tg[3] = bfhi(vg.y); tg[4] = bflo(vg.z); tg[5] = bfhi(vg.z); tg[6] = bflo(vg.w); tg[7] = bfhi(vg.w);
                        tu[0] = bflo(vu.x); tu[1] = bfhi(vu.x); tu[2] = bflo(vu.y); tu[3] = bfhi(vu.y); tu[4] = bflo(vu.z); tu[5] = bfhi(vu.z); tu[6] = bflo(vu.w); tu[7] = bfhi(vu.w); }
                    else if (prompt) {
#pragma unroll
                        for (int e = 0; e < 8; ++e) { tg[e] = 0.f; tu[e] = 0.f; } }
                    else { const float* sp = sconv + ((size_t)((m - MP) >> 2) * 2 + (2 + tt)) * F2;
#pragma unroll
                        for (int h = 0; h < 2; ++h) { const f32x4 vg = *(const f32x4*)(sp + f0 + 4 * h), vu = *(const f32x4*)(sp + FF + f0 + 4 * h);
#pragma unroll
                            for (int e = 0; e < 4; ++e) { tg[4 * h + e] = vg[e]; tu[4 * h + e] = vu[e]; } } }
#pragma unroll
                    for (int e = 0; e < 8; ++e) { if (back == 2) { p2g[e] = tg[e]; p2u[e] = tu[e]; } else { p1g[e] = tg[e]; p1u[e] = tu[e]; } }
                }
            }
            const u32x4 vg = *(const u32x4*)(U + (size_t)m * F2 + ug), vu = *(const u32x4*)(U + (size_t)m * F2 + uu);
            float cg[8], cu[8];
            cg[0] = bflo(vg.x); cg[1] = bfhi(vg.x); cg[2] = bflo(vg.y); cg[3] = bfhi(vg.y); cg[4] = bflo(vg.z); cg[5] = bfhi(vg.z); cg[6] = bflo(vg.w); cg[7] = bfhi(vg.w);
            cu[0] = bflo(vu.x); cu[1] = bfhi(vu.x); cu[2] = bflo(vu.y); cu[3] = bfhi(vu.y); cu[4] = bflo(vu.z); cu[5] = bfhi(vu.z); cu[6] = bflo(vu.w); cu[7] = bfhi(vu.w);
            float o[8];
#pragma unroll
            for (int e = 0; e < 8; ++e) { const float gg = wg[0][e] * p2g[e] + wg[1][e] * p1g[e] + wg[2][e] * cg[e] + bg[e], up = wu[0][e] * p2u[e] + wu[1][e] * p1u[e] + wu[2][e] * cu[e] + bu[e];
                o[e] = silu_f(gg) * up; p2g[e] = p1g[e]; p1g[e] = cg[e]; p2u[e] = p1u[e]; p1u[e] = cu[e]; }
            u32x4 w; w.x = pk2(o[0], o[1]); w.y = pk2(o[2], o[3]); w.z = pk2(o[4], o[5]); w.w = pk2(o[6], o[7]);
            *(u32x4*)(ACT + (size_t)m * FF + f0) = w;
        }
    }
}

__device__ __forceinline__ bf16x8 cat8(s16x4 a, s16x4 b) { return __builtin_shufflevector(a, b, 0, 1, 2, 3, 4, 5, 6, 7); }
typedef short v4i16_t __attribute__((ext_vector_type(4)));
__device__ __forceinline__ s16x4 vtr(const LAS unsigned char* p) { return __builtin_bit_cast(s16x4, __builtin_amdgcn_ds_read_tr16_b64_v4i16((LAS v4i16_t*)p)); }
#define LBAR() asm volatile("s_waitcnt lgkmcnt(0)\n\ts_barrier" ::: "memory")
constexpr int KN_P = 528, VN_P = 144, ST_P = 528;
constexpr int KN_OFF = 0, VN_OFF = 128 * KN_P, ST_OFF = VN_OFF + 128 * VN_P, RET_LDS_END = ST_OFF + 64 * ST_P;
static_assert(RET_LDS_END <= RING_BYTES, "retention LDS");
static_assert(XCH_OFF + XCH_BYTES <= LDS_BYTES, "LDS map");

__device__ __forceinline__ void ret_prompt_item(const Args& a, LAS unsigned char* lds, int item, int wave_s) {
    LAUNDER_TID();
    const int b = item >> 6, h = (item >> 3) & 7, sl = item & 7, fr = lane & 15, fq = lane >> 4;
    const bf16* PROJ = (const bf16*)(a.ws + WS_PROJ); bf16* OB = (bf16*)(a.ws + WS_OB);
    LAS unsigned char* Kn = lds + KN_OFF; LAS unsigned char* Vn = lds + VN_OFF; LAS unsigned char* St = lds + ST_OFF;
    const float l2g = gamma_l2(h);
    const int qb = (wave < 4) ? wave : 11 - wave;
    const float sdec = __builtin_amdgcn_exp2f(128.f * l2g), cross = __builtin_amdgcn_exp2f((float)(16 * qb + fr + 1) * l2g);
    for (int i = tid; i < 64 * ST_P / 16; i += NT) ((LAS u32x4*)St)[i] = (u32x4){0u, 0u, 0u, 0u};
    f32x4 S[2][4];
#pragma unroll
    for (int x = 0; x < 2; ++x)
#pragma unroll
        for (int y = 0; y < 4; ++y) S[x][y] = (f32x4){0.f, 0.f, 0.f, 0.f};
    u32x4 kst[8], vst[2]; bf16x8 qf[8];
    const char* kbase = (const char*)(PROJ + (size_t)b * SEQ * NPROJ + 2048 + h * DK);
    const char* vbase = (const char*)(PROJ + (size_t)b * SEQ * NPROJ + 4096 + h * DV + sl * 64);
    const char* qbase = (const char*)(PROJ + (size_t)b * SEQ * NPROJ + h * DK);
    char* obase = (char*)(OB + (size_t)b * SEQ * 4096 + h * DV + sl * 64);
    const unsigned klane = (unsigned)((tid >> 5) * NPROJ + (tid & 31) * 8) * 2u, vlane = (unsigned)((tid >> 3) * NPROJ + (tid & 7) * 8) * 2u;
    const unsigned qlane = (unsigned)((16 * qb + fr) * NPROJ + 8 * fq) * 2u, olane = (unsigned)((16 * qb + fr) * 4096 + 4 * fq) * 2u;
    constexpr size_t CH_IN = (size_t)128 * NPROJ * 2, CH_OUT = (size_t)128 * 4096 * 2;
#define RET_LOAD_KV(c) do { const char* kc = kbase + (size_t)(c) * CH_IN; const char* vc = vbase + (size_t)(c) * CH_IN; \
        _Pragma("unroll") for (int i = 0; i < 8; ++i) kst[i] = *(const u32x4*)(kc + (size_t)i * 16 * NPROJ * 2 + klane); \
        _Pragma("unroll") for (int i = 0; i < 2; ++i) vst[i] = *(const u32x4*)(vc + (size_t)i * 64 * NPROJ * 2 + vlane); } while (0)
#define RET_LOAD_Q(c) do { const char* qc = qbase + (size_t)(c) * CH_IN; \
        _Pragma("unroll") for (int kk = 0; kk < 8; ++kk) qf[kk] = *(const bf16x8*)(qc + 64 * kk + qlane); } while (0)
    RET_LOAD_KV(0); RET_LOAD_Q(0);
    LBAR();
    for (int c = 0; c < 16; ++c) {
#pragma unroll
        for (int i = 0; i < 8; ++i) { const int p = tid + NT * i; *(LAS u32x4*)(Kn + (p >> 5) * KN_P + (p & 31) * 16) = kst[i]; }
#pragma unroll
        for (int i = 0; i < 2; ++i) { const int p = tid + NT * i; *(LAS u32x4*)(Vn + (p >> 3) * VN_P + (p & 7) * 16) = vst[i]; }
        LBAR();
        u32x2 pk[8];
#pragma unroll
        for (int jj = 0; jj < 4; ++jj) {
            pk[2 * jj] = (u32x2){0u, 0u}; pk[2 * jj + 1] = (u32x2){0u, 0u};
            if (2 * jj <= qb) {
                f32x4 p0 = (f32x4){0.f, 0.f, 0.f, 0.f}, p1 = (f32x4){0.f, 0.f, 0.f, 0.f};
#pragma unroll
                for (int kk = 0; kk < 8; ++kk) {
                    const bf16x8 X0 = *(const LAS bf16x8*)(Kn + (32 * jj + fr) * KN_P + (32 * kk + 8 * fq) * 2);
                    const bf16x8 X1 = *(const LAS bf16x8*)(Kn + (32 * jj + 16 + fr) * KN_P + (32 * kk + 8 * fq) * 2);
                    p0 = __builtin_amdgcn_mfma_f32_16x16x32_bf16(X0, qf[kk], p0, 0, 0, 0);
                    p1 = __builtin_amdgcn_mfma_f32_16x16x32_bf16(X1, qf[kk], p1, 0, 0, 0); }
                if (2 * jj == qb) {
#pragma unroll
                    for (int i = 0; i < 4; ++i) { if (4 * fq + i > fr) p0[i] = 0.f; p1[i] = 0.f; } }
                else if (2 * jj + 1 == qb) {
#pragma unroll
                    for (int i = 0; i < 4; ++i) if (4 * fq + i > fr) p1[i] = 0.f; }
                pk[2 * jj].x = pk2(p0[0], p0[1]); pk[2 * jj].y = pk2(p0[2], p0[3]); pk[2 * jj + 1].x = pk2(p1[0], p1[1]); pk[2 * jj + 1].y = pk2(p1[2], p1[3]);
            }
        }
        if (c + 1 < 16) RET_LOAD_KV(c + 1);
        f32x4 o[4];
#pragma unroll
        for (int vb = 0; vb < 4; ++vb) { o[vb] = (f32x4){0.f, 0.f, 0.f, 0.f};
#pragma unroll
            for (int kk = 0; kk < 8; ++kk) { const bf16x8 X = *(const LAS bf16x8*)(St + (16 * vb + fr) * ST_P + (32 * kk + 8 * fq) * 2); o[vb] = __builtin_amdgcn_mfma_f32_16x16x32_bf16(X, qf[kk], o[vb], 0, 0, 0); } }
        if (c + 1 < 16) RET_LOAD_Q(c + 1);
#pragma unroll
        for (int jj = 0; jj < 4; ++jj) {
            if (2 * jj <= qb) {
                const u32x4 yw = (u32x4){pk[2 * jj].x, pk[2 * jj].y, pk[2 * jj + 1].x, pk[2 * jj + 1].y};
                const bf16x8 Y = __builtin_bit_cast(bf16x8, yw);
#pragma unroll
                for (int vb = 0; vb < 4; ++vb) {
                    const s16x4 t0 = vtr(Vn + (32 * jj + 4 * fq + (fr >> 2)) * VN_P + (16 * vb + 4 * (fr & 3)) * 2);
                    const s16x4 t1 = vtr(Vn + (32 * jj + 16 + 4 * fq + (fr >> 2)) * VN_P + (16 * vb + 4 * (fr & 3)) * 2);
                    o[vb] = __builtin_amdgcn_mfma_f32_16x16x32_bf16(cat8(t0, t1), Y, o[vb], 0, 0, 0);
                }
            }
        }
        { char* oc = obase + (size_t)c * CH_OUT;
#pragma unroll
            for (int vb = 0; vb < 4; ++vb) { u32x2 w; w.x = pk2(o[vb][0] * cross, o[vb][1] * cross); w.y = pk2(o[vb][2] * cross, o[vb][3] * cross); *(u32x2*)(oc + 32 * vb + olane) = w; } }
        LBAR();
#pragma unroll
        for (int kk = 0; kk < 4; ++kk) {
            bf16x8 Yv[4];
#pragma unroll
            for (int vb = 0; vb < 4; ++vb) {
                const s16x4 t0 = vtr(Vn + (32 * kk + 8 * fq + (fr >> 2)) * VN_P + (16 * vb + 4 * (fr & 3)) * 2);
                const s16x4 t1 = vtr(Vn + (32 * kk + 8 * fq + 4 + (fr >> 2)) * VN_P + (16 * vb + 4 * (fr & 3)) * 2);
                Yv[vb] = cat8(t0, t1); }
#pragma unroll
            for (int kbl = 0; kbl < 2; ++kbl) { const int kb = 2 * wave + kbl;
                const s16x4 t0 = vtr(Kn + (32 * kk + 8 * fq + (fr >> 2)) * KN_P + (16 * kb + 4 * (fr & 3)) * 2);
                const s16x4 t1 = vtr(Kn + (32 * kk + 8 * fq + 4 + (fr >> 2)) * KN_P + (16 * kb + 4 * (fr & 3)) * 2);
                const bf16x8 X = cat8(t0, t1);
#pragma unroll
                for (int vb = 0; vb < 4; ++vb) S[kbl][vb] = __builtin_amdgcn_mfma_f32_16x16x32_bf16(X, Yv[vb], S[kbl][vb], 0, 0, 0); }
        }
#pragma unroll
        for (int kbl = 0; kbl < 2; ++kbl)
#pragma unroll
            for (int vb = 0; vb < 4; ++vb) { S[kbl][vb] = S[kbl][vb] * sdec; u32x2 w; w.x = pk2(S[kbl][vb][0], S[kbl][vb][1]); w.y = pk2(S[kbl][vb][2], S[kbl][vb][3]);
                *(LAS u32x2*)(St + (16 * vb + fr) * ST_P + (16 * (2 * wave + kbl) + 4 * fq) * 2) = w; }
        LBAR();
    }
#undef RET_LOAD_KV
#undef RET_LOAD_Q
    float* so = a.out + O_RP + ((size_t)(b * RH + h) * DK) * DV + sl * 64;
#pragma unroll
    for (int kbl = 0; kbl < 2; ++kbl)
#pragma unroll
        for (int vb = 0; vb < 4; ++vb)
#pragma unroll
            for (int i = 0; i < 4; ++i) so[(size_t)(16 * (2 * wave + kbl) + 4 * fq + i) * DV + 16 * vb + fr] = S[kbl][vb][i];
}

__device__ __forceinline__ void ret_sample_item(const Args& a, LAS unsigned char* lds, int item, int wave_s) {
    LAUNDER_TID();
    const int b = item >> 3, h = item & 7;
    const bf16* PROJ = (const bf16*)(a.ws + WS_PROJ); bf16* OB = (bf16*)(a.ws + WS_OB);
    LAS float* qs = (LAS float*)lds;
    LAS float* ks = qs + 1024;
    LAS float* scs = ks + 1024;
    LAS float* stat = scs + 16;
    LAS float* red = stat + 16 + 16;
    const float l2g = gamma_l2(h);
    const size_t r0 = (size_t)MP + (size_t)b * DS;
    {
        const int n = tid >> 7, c = (tid & 127) * 2;
        const unsigned wq = *(const unsigned*)(PROJ + (r0 + n) * NPROJ + h * DK + c), wk = *(const unsigned*)(PROJ + (r0 + n) * NPROJ + 2048 + h * DK + c);
        qs[n * 256 + c] = bflo(wq); qs[n * 256 + c + 1] = bfhi(wq); ks[n * 256 + c] = bflo(wk); ks[n * 256 + c + 1] = bfhi(wk);
    }
    __syncthreads();
#pragma unroll
    for (int pp = 0; pp < 2; ++pp) { const int pr = 2 * wave + pp, n = pr >> 2, m = pr & 3; float s = 0.f;
#pragma unroll
        for (int j = 0; j < 4; ++j) s += qs[n * 256 + lane + 64 * j] * ks[m * 256 + lane + 64 * j];
        s = wave_sum(s);
        if (lane == 0) scs[pr] = (m <= n) ? s * __builtin_amdgcn_exp2f((float)(n - m) * l2g) : 0.f; }
    __syncthreads();
    { const int m = tid >> 7, c = (tid & 127) * 2; const float kd = __builtin_amdgcn_exp2f((float)(3 - m) * l2g); ks[m * 256 + c] *= kd; ks[m * 256 + c + 1] *= kd; }
    __syncthreads();
    const int kq = tid >> 7, v4 = tid & 127;
    f32x4 vv[4];
#pragma unroll
    for (int m = 0; m < 4; ++m) { const u32x2 w = *(const u32x2*)(PROJ + (r0 + m) * NPROJ + 4096 + h * DV + 4 * v4); vv[m] = (f32x4){bflo(w.x), bfhi(w.x), bflo(w.y), bfhi(w.y)}; }
    const float sdec = __builtin_amdgcn_exp2f(4.f * l2g);
    const char* Sin = (const char*)(a.in[5] + ((size_t)(b * RH + h) * DK) * DV);
    char* Sout = (char*)(a.out + O_RS + ((size_t)(b * RH + h) * DK) * DV);
    const unsigned slane = (unsigned)(kq * 64 * DV + 4 * v4) * 4u;
    f32x4 oa[4];
#pragma unroll
    for (int n = 0; n < 4; ++n) oa[n] = (f32x4){0.f, 0.f, 0.f, 0.f};
    f32x4 sa[16], sb[16];
#define SLOAD(buf, g) do { _Pragma("unroll") for (int i = 0; i < 16; ++i) buf[i] = __builtin_nontemporal_load((const f32x4*)(Sin + (size_t)((g) * 16 + i) * DV * 4 + slane)); } while (0)
#define SCOMP(buf, g) do { _Pragma("unroll") for (int i = 0; i < 16; ++i) { const int k = kq * 64 + (g) * 16 + i; \
        _Pragma("unroll") for (int n = 0; n < 4; ++n) oa[n] += buf[i] * qs[n * 256 + k]; \
        f32x4 sn = buf[i] * sdec; \
        _Pragma("unroll") for (int m = 0; m < 4; ++m) sn += vv[m] * ks[m * 256 + k]; \
        __builtin_nontemporal_store(sn, (f32x4*)(Sout + (size_t)((g) * 16 + i) * DV * 4 + slane)); } } while (0)
    SLOAD(sa, 0); SLOAD(sb, 1); SCOMP(sa, 0); SLOAD(sa, 2); SCOMP(sb, 1); SLOAD(sb, 3); SCOMP(sa, 2); SCOMP(sb, 3);
#undef SLOAD
#undef SCOMP
#pragma unroll
    for (int n = 0; n < 4; ++n) *(LAS f32x4*)(red + ((kq * 4 + n) * 512 + 4 * v4)) = oa[n];
    __syncthreads();
    { const int n = tid >> 7;
        f32x4 o = *(LAS f32x4*)(red + ((0 * 4 + n) * 512 + 4 * v4)) + *(LAS f32x4*)(red + ((1 * 4 + n) * 512 + 4 * v4)) + *(LAS f32x4*)(red + ((2 * 4 + n) * 512 + 4 * v4)) + *(LAS f32x4*)(red + ((3 * 4 + n) * 512 + 4 * v4));
        o = o * __builtin_amdgcn_exp2f((float)(n + 1) * l2g);
#pragma unroll
        for (int m = 0; m < 4; ++m) o += vv[m] * scs[n * 4 + m];
        float s1 = (o[0] + o[1]) + (o[2] + o[3]), s2 = (o[0] * o[0] + o[1] * o[1]) + (o[2] * o[2] + o[3] * o[3]);
        s1 = wave_sum(s1); s2 = wave_sum(s2);
        if (lane == 0) { stat[wave * 2] = s1; stat[wave * 2 + 1] = s2; }
        __syncthreads();
        const float t1 = stat[(2 * n) * 2] + stat[(2 * n + 1) * 2], t2 = stat[(2 * n) * 2 + 1] + stat[(2 * n + 1) * 2 + 1];
        const float mu = t1 * (1.f / DV), var = t2 * (1.f / DV) - mu * mu, rstd = __builtin_amdgcn_rsqf(var + EPS);
        const u32x2 gw = *(const u32x2*)(PROJ + (r0 + n) * NPROJ + 8192 + h * DV + 4 * v4);
        u32x2 w; w.x = pk2(bflo(gw.x) * (o[0] - mu) * rstd, bfhi(gw.x) * (o[1] - mu) * rstd); w.y = pk2(bflo(gw.y) * (o[2] - mu) * rstd, bfhi(gw.y) * (o[3] - mu) * rstd);
        *(u32x2*)(OB + (r0 + n) * 4096 + h * DV + 4 * v4) = w;
    }
    __syncthreads();
}

__device__ __forceinline__ void act_fixup(const Args& a, int layer, int pm, int wave_s) {
    LAUNDER_TID();
    if ((pm & 7) == 0 || pm >= MP / 256) return;
    const float* ub = (const float*)(a.ws + WS_UBND); bf16* ACT = (bf16*)(a.ws + WS_ACT);
    const float* cw = a.in[16] + (size_t)layer * 3 * F2; const float* cb = a.in[17] + (size_t)layer * F2;
    for (int g4 = tid; g4 < FF / 4; g4 += NT) {
        const int f = 4 * g4, ug = 256 * (f >> 7) + (f & 127), uu = ug + 128;
        const float* pr = ub + (size_t)((pm - 1) * 4) * F2; const float* cu_ = ub + (size_t)(pm * 4) * F2;
        const f32x4 m2g = *(const f32x4*)(pr + 2 * F2 + ug), m1g = *(const f32x4*)(pr + 3 * F2 + ug), z0g = *(const f32x4*)(cu_ + ug), z1g = *(const f32x4*)(cu_ + F2 + ug);
        const f32x4 m2u = *(const f32x4*)(pr + 2 * F2 + uu), m1u = *(const f32x4*)(pr + 3 * F2 + uu), z0u = *(const f32x4*)(cu_ + uu), z1u = *(const f32x4*)(cu_ + F2 + uu);
        const f32x4 w0g = *(const f32x4*)(cw + f), w1g = *(const f32x4*)(cw + F2 + f), w2g = *(const f32x4*)(cw + 2 * F2 + f), bg = *(const f32x4*)(cb + f);
        const f32x4 w0u = *(const f32x4*)(cw + FF + f), w1u = *(const f32x4*)(cw + F2 + FF + f), w2u = *(const f32x4*)(cw + 2 * F2 + FF + f), bu = *(const f32x4*)(cb + FF + f);
        const f32x4 g0 = w0g * m2g + w1g * m1g + w2g * z0g + bg, u0 = w0u * m2u + w1u * m1u + w2u * z0u + bu;
        const f32x4 g1 = w0g * m1g + w1g * z0g + w2g * z1g + bg, u1 = w0u * m1u + w1u * z0u + w2u * z1u + bu;
        u32x2 o0, o1;
        o0.x = pk2(silu_f(g0[0]) * u0[0], silu_f(g0[1]) * u0[1]); o0.y = pk2(silu_f(g0[2]) * u0[2], silu_f(g0[3]) * u0[3]);
        o1.x = pk2(silu_f(g1[0]) * u1[0], silu_f(g1[1]) * u1[1]); o1.y = pk2(silu_f(g1[2]) * u1[2], silu_f(g1[3]) * u1[3]);
        *(u32x2*)(ACT + (size_t)(pm * 256) * FF + f) = o0; *(u32x2*)(ACT + (size_t)(pm * 256 + 1) * FF + f) = o1;
    }
}

__device__ __forceinline__ void gn_phase(const Args& a, int wave_s) {
    LAUNDER_TID();
    const int G = gridDim.x, gw = blockIdx.x * NWAVES + wave, NGW = G * NWAVES;
    const bf16* PROJ = (const bf16*)(a.ws + WS_PROJ); bf16* OB = (bf16*)(a.ws + WS_OB);
    for (int it0 = gw * 4; it0 < MP * RH; it0 += NGW * 4) {
        u32x4 ov[4], gv[4];
#pragma unroll
        for (int q = 0; q < 4; ++q) { const int it = it0 + q, row = it >> 3, h = it & 7;
            ov[q] = *(const u32x4*)(OB + (size_t)row * 4096 + h * DV + 8 * lane); gv[q] = *(const u32x4*)(PROJ + (size_t)row * NPROJ + 8192 + h * DV + 8 * lane); }
#pragma unroll
        for (int q = 0; q < 4; ++q) { const int it = it0 + q, row = it >> 3, h = it & 7;
            float o[8] = {bflo(ov[q].x), bfhi(ov[q].x), bflo(ov[q].y), bfhi(ov[q].y), bflo(ov[q].z), bfhi(ov[q].z), bflo(ov[q].w), bfhi(ov[q].w)};
            const float g[8] = {bflo(gv[q].x), bfhi(gv[q].x), bflo(gv[q].y), bfhi(gv[q].y), bflo(gv[q].z), bfhi(gv[q].z), bflo(gv[q].w), bfhi(gv[q].w)};
            float s1 = 0.f, s2 = 0.f;
#pragma unroll
            for (int e = 0; e < 8; ++e) { s1 += o[e]; s2 += o[e] * o[e]; }
            s1 = wave_sum(s1); s2 = wave_sum(s2);
            const float mu = s1 * (1.f / DV), var = s2 * (1.f / DV) - mu * mu, rstd = __builtin_amdgcn_rsqf(var + EPS);
#pragma unroll
            for (int e = 0; e < 8; ++e) o[e] = g[e] * (o[e] - mu) * rstd;
            u32x4 w; w.x = pk2(o[0], o[1]); w.y = pk2(o[2], o[3]); w.z = pk2(o[4], o[5]); w.w = pk2(o[6], o[7]);
            *(u32x4*)(OB + (size_t)row * 4096 + h * DV + 8 * lane) = w; }
    }
}

__device__ __forceinline__ void final_phase(const Args& a, const bf16* xs, const float* ssq, int wave_s) {
    LAUNDER_TID();
    const int G = gridDim.x, gw = blockIdx.x * NWAVES + wave, NGW = G * NWAVES;
    const float* gf = a.in[10];
    for (int row = gw; row < M; row += NGW) {
        const float rs = row_rstd(ssq, row);
#pragma unroll
        for (int j = 0; j < 4; ++j) { const int c = 8 * lane + 512 * j; const u32x4 w = *(const u32x4*)(xs + (size_t)row * D + c);
            const f32x4 g0 = *(const f32x4*)(gf + c), g1 = *(const f32x4*)(gf + c + 4);
            *(f32x4*)(a.out + (size_t)row * D + c) = (f32x4){bflo(w.x), bfhi(w.x), bflo(w.y), bfhi(w.y)} * rs * g0;
            *(f32x4*)(a.out + (size_t)row * D + c + 4) = (f32x4){bflo(w.z), bfhi(w.z), bflo(w.w), bfhi(w.w)} * rs * g1; }
    }
}

constexpr int NPH = 15;
__global__ void __launch_bounds__(NT, 2) fwd_kernel(Args args) {
    extern __shared__ __attribute__((aligned(16))) unsigned char lds_raw[];
    LAS unsigned char* lds = (LAS unsigned char*)lds_raw;
    const int tid = threadIdx.x;
    const int wave_s = __builtin_amdgcn_readfirstlane(tid >> 6);
    const int G = gridDim.x;
    unsigned char* ws = args.ws;
    for (int u = tid; u < (LDS_BYTES - LDSCTL_OFF) / 4; u += NT) ((LAS unsigned*)(lds + LDSCTL_OFF))[u] = 0u;
    __syncthreads();
    XcdBarrier bar; bar.bar = (unsigned*)(ws + WS_CTL) + CW_BAR; bar.x = 0; bar.st = nullptr;
    const int lo = args.ph_lo, hi = args.ph_hi;
    if (hi - lo > 1) bar = xcd_barrier_post((unsigned*)(ws + WS_CTL) + CW_BAR, (volatile LAS unsigned*)(lds + MISC_OFF) + 8);
#define IN(k) (lo <= (k) && (k) < hi)
#define SEAM(k) do { if (IN(k) && IN((k) + 1)) xcd_barrier(bar, wave_s); } while (0)
#define SEAM2(k, k2) do { if (IN(k) && IN(k2)) xcd_barrier(bar, wave_s); } while (0)
    float* XSA = (float*)(ws + WS_XSA); float* XSB = (float*)(ws + WS_XSB);
    bf16* XB0 = (bf16*)(ws + WS_XB0); bf16* XB1 = (bf16*)(ws + WS_XB1);
#define SSQV(k) ((float*)(ws + WS_SSQV + (k) * SSQV_STRIDE))
#define SSQO(k) SSQV(rep_ ? 6 : (k))
    pg8::StaticOrder S;

    if (IN(0)) REP(0) { p0_prologue(args, lds, wave_s); }
    SEAM(0);
#define GEMM_RUN(XT, EPI, ...) do { S.init((XT) ? MP : M, NN_, G, (int)blockIdx.x); const pg8::EPI e_ __VA_ARGS__; const pg8::EpiDrive<pg8::EPI> E(e_); pg8::gemm_phase<pg8::EpiDrive<pg8::EPI>, XT>(lds, g, S, E, wave_s); } while (0)
#define EMB_FILL(l) do { const int nu_ = (M / 256) * (F2 / 256), r_ = (nu_ + G - 1) / G, ns_ = r_ * G - nu_; \
        pg8::Gemm g{(const bf16*)(ws + WS_PB) + (size_t)(l) * M * PLE, (const bf16*)(ws + WS_WP) + (size_t)(l) * D * PLE, PLE, PLE, 0}; \
        if (ns_ > 0) S.init(MP, D, ns_, (int)blockIdx.x - (G - ns_)); else S.init(MP, D, G, (int)blockIdx.x); \
        const pg8::EpiBf16 e_{(bf16*)(ws + ((l) ? WS_EMB1 : WS_EMB0)), nullptr}; const pg8::EpiDrive<pg8::EpiBf16> E(e_); pg8::gemm_phase<pg8::EpiDrive<pg8::EpiBf16>, true>(lds, g, S, E, wave_s); } while (0)
    if (IN(1)) REP(1) {
        { constexpr int NN_ = D; pg8::Gemm g{(const bf16*)(ws + WS_DPRE), (const bf16*)(ws + WS_WPOOL), D, 512, 2}; GEMM_RUN(true, EpiRes, {args.in[0], args.in[1], nullptr, XB0, SSQO(0), args.in[12], nullptr}); }
    }
    SEAM(1);
    if (IN(2)) REP(2) { constexpr int NN_ = F2; pg8::Gemm g{XB0, (const bf16*)(ws + WS_WUP), D, D, 0}; S.init(M, NN_, G, (int)blockIdx.x); const pg8::EpiUpAct E{(bf16*)(ws + WS_ACT), SSQV(0), args.out + O_CP, args.out + O_CS, args.in[16], args.in[17], args.in[6], (float*)(ws + WS_UBND), (LAS float*)(lds + XCH_OFF)}; pg8::gemm_phase<pg8::EpiUpAct, false>(lds, g, S, E, wave_s); }
    if (IN(2)) EMB_FILL(0);
#if defined(PROBE_VAR)
    if (IN(2)) { pg8::Gemm g{XB0, (const bf16*)(ws + WS_WUP), D, D, 0}; S.init(M, F2, G, (int)blockIdx.x); const pg8::EpiBf16 e_{(bf16*)(ws + WS_U + 16 * MiB), nullptr}; const pg8::EpiDrive<pg8::EpiBf16> E(e_); pg8::gemm_phase<pg8::EpiDrive<pg8::EpiBf16>, false, PROBE_VAR>(lds, g, S, E, wave_s); }
#endif
    SEAM2(2, 4);
    if (IN(4)) REP(4) { constexpr int NN_ = D; { pg8::Unit u_; S.init(MP, D, G, (int)blockIdx.x); for (int i = 0; S.next(i, u_); ++i) act_fixup(args, 0, u_.pm, wave_s); asm volatile("s_waitcnt vmcnt(0)" ::: "memory"); __syncthreads(); }
        pg8::Gemm g{(const bf16*)(ws + WS_ACT), (const bf16*)(ws + WS_WDN), FF, FF, 0}; GEMM_RUN(true, EpiRes, {nullptr, nullptr, XB0, XB1, SSQO(1), nullptr, nullptr}); }
    SEAM(4);
    if (IN(5)) REP(5) { constexpr int NN_ = D; pg8::Gemm g{XB1, (const bf16*)(ws + WS_WG), D, D, 0}; GEMM_RUN(true, EpiPle, {XB1, (const bf16*)(ws + WS_EMB0), SSQV(1), XB0, SSQO(2)}); }
    SEAM(5);
    if (IN(6)) REP(6) { constexpr int NN_ = NPROJ; pg8::Gemm g{XB0, (const bf16*)(ws + WS_WIN), D, D, 0}; S.init(MP, NN_, G, (int)blockIdx.x); const pg8::EpiRetIn2 E{(bf16*)(ws + WS_PROJ), SSQV(2), (const float*)(ws + WS_ROPE)}; pg8::gemm_phase<pg8::EpiRetIn2, true>(lds, g, S, E, wave_s); }
    SEAM(6);
    if (IN(7)) REP(7) {
        const int bx = blockIdx.x, half = (bx >> 3) & 1, rank = (bx >> 4) * 8 + (bx & 7), nh = G / 2;
        if (G % 16 != 0) { for (int it = bx; it < NB * RH * 8; it += G) ret_prompt_item(args, lds, it, wave_s); __syncthreads(); for (int it = bx; it < DB * RH; it += G) ret_sample_item(args, lds, it, wave_s); }
        else if (half == 0) {
            const int prank = (G == 256) ? (((bx & 7) * 2 + (bx >> 7)) * 8 + ((bx >> 4) & 7)) : rank;
            REP(16) for (int it = prank; it < NB * RH * 8; it += nh) ret_prompt_item(args, lds, it, wave_s); }
        else { REP(17) for (int it = rank; it < DB * RH; it += nh) ret_sample_item(args, lds, it, wave_s); }
    }
    SEAM(7);
    if (IN(8)) gn_phase(args, wave_s);
    SEAM(8);
    if (IN(9)) REP(9) { constexpr int NN_ = D; pg8::Gemm g{(const bf16*)(ws + WS_OB), (const bf16*)(ws + WS_WOUT), 4096, 4096, 0}; GEMM_RUN(true, EpiRes, {nullptr, nullptr, XB0, XB1, SSQO(3), nullptr, nullptr}); }
    SEAM(9);
    if (IN(10)) REP(10) { constexpr int NN_ = F2; pg8::Gemm g{XB1, (const bf16*)(ws + WS_WUP) + (size_t)F2 * D, D, D, 0}; S.init(M, NN_, G, (int)blockIdx.x); const pg8::EpiUpAct E{(bf16*)(ws + WS_ACT), SSQV(3), args.out + O_CP + (size_t)NB * 2 * F2, args.out + O_CS + (size_t)DB * 2 * F2, args.in[16] + (size_t)3 * F2, args.in[17] + F2, args.in[6] + (size_t)DB * 2 * F2, (float*)(ws + WS_UBND), (LAS float*)(lds + XCH_OFF)}; pg8::gemm_phase<pg8::EpiUpAct, false>(lds, g, S, E, wave_s); }
    if (IN(10)) EMB_FILL(1);
    SEAM2(10, 12);
    if (IN(12)) REP(12) { constexpr int NN_ = D; { pg8::Unit u_; S.init(MP, D, G, (int)blockIdx.x); for (int i = 0; S.next(i, u_); ++i) act_fixup(args, 1, u_.pm, wave_s); asm volatile("s_waitcnt vmcnt(0)" ::: "memory"); __syncthreads(); }
        pg8::Gemm g{(const bf16*)(ws + WS_ACT), (const bf16*)(ws + WS_WDN) + (size_t)D * FF, FF, FF, 0}; GEMM_RUN(true, EpiRes, {nullptr, nullptr, XB1, XB0, SSQO(4), nullptr, nullptr}); }
    SEAM(12);
    const bool fuse_fin = (G == (MP / 256) * (D / 256));
    if (IN(13)) { constexpr int NN_ = D; pg8::Gemm g{XB0, (const bf16*)(ws + WS_WG) + (size_t)D * D, D, D, 0};
        if (fuse_fin) { S.init(MP, NN_, G, (int)blockIdx.x);
            const pg8::EpiPleFin E{XB0, (const bf16*)(ws + WS_EMB1), SSQV(4), SSQV(5), args.in[10], args.out, (unsigned*)(ws + WS_CTL) + CW_PCNT, (unsigned*)(ws + WS_CTL)};
            pg8::gemm_phase<pg8::EpiPleFin, true>(lds, g, S, E, wave_s); }
        else { const int rep_ = 0; (void)rep_; GEMM_RUN(true, EpiPle, {XB0, (const bf16*)(ws + WS_EMB1), SSQV(4), XB1, SSQV(5)}); } }
    if (!fuse_fin) { SEAM(13);
        if (IN(14)) final_phase(args, XB1, SSQV(5), wave_s); }
#undef IN
#undef SEAM
}

extern "C" void kernel_launch(void* const* d_in, const int* in_sizes, int n_in, void* d_out, int out_size, void* d_ws, size_t ws_size, hipStream_t stream) {
    static int grid = 0;
    if (grid == 0) {
        if (n_in != 21 || (size_t)out_size != O_END || ws_size < WS_END) { fprintf(stderr, "kernel_launch: unexpected sizes n_in %d out %d ws %zu\n", n_in, out_size, ws_size); grid = -1; return; }
        int dev = 0, cus = 0, per_cu = 0;
        if (hipGetDevice(&dev) != hipSuccess || hipDeviceGetAttribute(&cus, hipDeviceAttributeMultiprocessorCount, dev) != hipSuccess) { grid = -1; return; }
        if (hipFuncSetAttribute((const void*)fwd_kernel, hipFuncAttributeMaxDynamicSharedMemorySize, LDS_BYTES) != hipSuccess) { fprintf(stderr, "kernel_launch: hipFuncSetAttribute failed\n"); grid = -1; return; }
        if (hipOccupancyMaxActiveBlocksPerMultiprocessor(&per_cu, (const void*)fwd_kernel, NT, LDS_BYTES) != hipSuccess || per_cu < 1) { fprintf(stderr, "kernel_launch: occupancy query says %d\n", per_cu); }
        (void)hipGetLastError();
        grid = cus;
    }
    if (grid < 0) return;
    if (hipMemsetAsync((char*)d_ws + WS_CTL, 0, CTL_ZERO_BYTES, stream) != hipSuccess) return;
    Args a{};
    for (int i = 0; i < 21; ++i) a.in[i] = (const float*)d_in[i];
    a.out = (float*)d_out; a.ws = (unsigned char*)d_ws;
#if MK_ONE_LAUNCH
    a.ph_lo = 0; a.ph_hi = NPH;
    hipLaunchKernelGGL(fwd_kernel, dim3(grid), dim3(NT), LDS_BYTES, stream, a);
#else
    for (int p = 0; p < NPH; ++p) { a.ph_lo = p; a.ph_hi = p + 1; hipLaunchKernelGGL(fwd_kernel, dim3(grid), dim3(NT), LDS_BYTES, stream, a); }
#endif
}
```
